# Optimizing an MI355X kernel written in HIP

```python
import jax, jax.numpy as jnp
from jax import lax
import numpy as np

D_MODEL = 1024
BATCH = 2
SEQ = 8192
DEPTH = 1
DEC_BATCH = 2
DEC_SEQ = 16384
PAST_LEN = 128

HEAD_DIM = 64
A_PAIRS = ((128, 1), (512, 4), (2048, 16))
A_SLOTS = 4
A_HEADS = A_SLOTS * len(A_PAIRS)
A_OUT = A_SLOTS * HEAD_DIM
B_Q_HEADS = 8
B_KV_HEADS = 2
B_HALF_WINDOW = 128
B_OUT = B_Q_HEADS * HEAD_DIM
D_FF = 2816
A_W = A_HEADS * HEAD_DIM
B_KV = B_KV_HEADS * HEAD_DIM
IN_SPLITS = (A_W, 2 * A_W, 3 * A_W, 3 * A_W + B_OUT, 3 * A_W + B_OUT + B_KV)
D_IN = 3 * A_W + B_OUT + 2 * B_KV
NORM_EPS = 1e-6
MASK_VALUE = -1e30

kernel_name = "hybrid_dilated_window_gqa_macaron_encoder"


def rms_norm(x, g):
    xf = x.astype(jnp.float32)
    y = xf * lax.rsqrt(jnp.mean(xf * xf, axis=-1, keepdims=True) + NORM_EPS)
    return (y * g.astype(jnp.float32)).astype(x.dtype)


def swiglu(x, w_gate, w_up, w_down):
    return (jax.nn.silu(x @ w_gate) * (x @ w_up)) @ w_down


def alibi_slopes(n):
    return 2.0 ** (-8.0 * jnp.arange(1, n + 1, dtype=jnp.float32) / n)


def banded_attention(q, k, v, half, dist_scale, slopes, sink=None):
    B, L, H, Dh = q.shape
    Hk = k.shape[2]
    G = H // Hk
    blk = half
    nb = -(-L // blk)
    Lp = nb * blk
    pad = Lp - L
    q = jnp.pad(q, ((0, 0), (0, pad), (0, 0), (0, 0)))
    kv_pad = ((0, 0), (blk, pad + blk), (0, 0), (0, 0))
    k = jnp.pad(k, kv_pad)
    v = jnp.pad(v, kv_pad)

    def band(t):
        return jnp.concatenate(
            [t[:, j * blk: j * blk + Lp].reshape(B, nb, blk, Hk, Dh) for j in range(3)], axis=2)

    kb, vb = band(k), band(v)
    qb = q.reshape(B, nb, blk, Hk, G, Dh)
    s = jnp.einsum('bnqhgd,bnkhd->bnhgqk', qb, kb).astype(jnp.float32) * (Dh ** -0.5)
    rel = jnp.arange(3 * blk)[None, :] - blk - jnp.arange(blk)[:, None]
    key_pos = jnp.arange(nb)[:, None] * blk - blk + jnp.arange(3 * blk)[None, :]
    valid = (jnp.abs(rel)[None] <= half) & ((key_pos >= 0) & (key_pos < L))[:, None, :]
    dist = (jnp.abs(rel) * dist_scale).astype(jnp.float32)
    s = s - slopes.reshape(Hk, G)[:, :, None, None] * dist
    s = jnp.where(valid[None, :, None, None], s, MASK_VALUE)
    lse = jax.nn.logsumexp(s, axis=-1)
    if sink is not None:
        lse = jnp.logaddexp(lse, sink.astype(jnp.float32).reshape(Hk, G)[:, :, None])
    p = jnp.exp(s - lse[..., None]).astype(v.dtype)
    o = jnp.einsum('bnhgqk,bnkhd->bnqhgd', p, vb).reshape(B, Lp, H, Dh)[:, :L]
    lse = lse.transpose(0, 1, 4, 2, 3).reshape(B, Lp, H)[:, :L]
    return o, lse


def to_residues(t, d):
    B, T, h, Dh = t.shape
    return t.reshape(B, T // d, d, h, Dh).transpose(0, 2, 1, 3, 4).reshape(B * d, T // d, h, Dh)


def from_residues(t, B, d):
    L = t.shape[1]
    rest = t.shape[2:]
    return t.reshape((B, d, L) + rest).swapaxes(1, 2).reshape((B, L * d) + rest)


def dilated_attention(q, k, v):
    B = q.shape[0]
    slopes = alibi_slopes(A_HEADS).reshape(len(A_PAIRS), A_SLOTS)
    outs, lses = [], []
    for gi, (w, d) in enumerate(A_PAIRS):
        sl = slice(gi * A_SLOTS, (gi + 1) * A_SLOTS)
        o, lse = banded_attention(to_residues(q[:, :, sl], d), to_residues(k[:, :, sl], d),
                                  to_residues(v[:, :, sl], d), w // (2 * d), d, slopes[gi])
        outs.append(from_residues(o, B, d))
        lses.append(from_residues(lse, B, d))
    outs = jnp.stack(outs, axis=0)
    alpha = jax.nn.softmax(jnp.stack(lses, axis=0), axis=0)
    return jnp.sum(alpha[..., None] * outs, axis=0).astype(q.dtype)


def encoder_layer(x, ffn1_norm, ffn1_w_gate, ffn1_w_up, ffn1_w_down, mix_norm, w_in,
                  a_q_norm, a_k_norm, b_q_norm, b_k_norm, b_sink, w_proj_a, w_proj_b,
                  w_gate, b_gate, w_out, ffn2_norm, ffn2_w_gate, ffn2_w_up, ffn2_w_down, final_norm):
    B, T, _ = x.shape
    h = x + 0.5 * swiglu(rms_norm(x, ffn1_norm), ffn1_w_gate, ffn1_w_up, ffn1_w_down)
    u = rms_norm(h, mix_norm)
    qa, ka, va, qb, kb, vb = jnp.split(u @ w_in, IN_SPLITS, axis=-1)
    qa = rms_norm(qa.reshape(B, T, A_HEADS, HEAD_DIM), a_q_norm)
    ka = rms_norm(ka.reshape(B, T, A_HEADS, HEAD_DIM), a_k_norm)
    va = va.reshape(B, T, A_HEADS, HEAD_DIM)
    qb = rms_norm(qb.reshape(B, T, B_Q_HEADS, HEAD_DIM), b_q_norm)
    kb = rms_norm(kb.reshape(B, T, B_KV_HEADS, HEAD_DIM), b_k_norm)
    vb = vb.reshape(B, T, B_KV_HEADS, HEAD_DIM)
    ya = dilated_attention(qa, ka, va).reshape(B, T, A_OUT)
    yb, _ = banded_attention(qb, kb, vb, B_HALF_WINDOW, 1, alibi_slopes(B_Q_HEADS), b_sink)
    yb = yb.reshape(B, T, B_OUT)
    ga, gb = jnp.split(jax.nn.sigmoid(u @ w_gate + b_gate), 2, axis=-1)
    m = ga * (ya @ w_proj_a) + gb * (yb @ w_proj_b)
    h = h + m @ w_out
    h = h + 0.5 * swiglu(rms_norm(h, ffn2_norm), ffn2_w_gate, ffn2_w_up, ffn2_w_down)
    return rms_norm(h, final_norm)


def setup_inputs(seed: int = 0) -> dict:
    key = jax.random.key(seed)
    ks = jax.random.split(key, 24)
    f32 = jnp.float32

    def w(k, shape, fan_in):
        return jax.random.normal(k, (DEPTH,) + shape, f32) * (fan_in ** -0.5)

    def gain(k, n):
        return 1.0 + 0.02 * jax.random.normal(k, (DEPTH, n), f32)

    return {
        "x_prompt": jax.random.normal(ks[0], (BATCH, SEQ, D_MODEL), f32),
        "x_sample": jax.random.normal(ks[1], (DEC_BATCH, DEC_SEQ, D_MODEL), f32),
        "ffn1_norm": gain(ks[2], D_MODEL),
        "ffn1_w_gate": w(ks[3], (D_MODEL, D_FF), D_MODEL),
        "ffn1_w_up": w(ks[4], (D_MODEL, D_FF), D_MODEL),
        "ffn1_w_down": w(ks[5], (D_FF, D_MODEL), D_FF),
        "mix_norm": gain(ks[6], D_MODEL),
        "w_in": w(ks[7], (D_MODEL, D_IN), D_MODEL),
        "a_q_norm": gain(ks[8], HEAD_DIM),
        "a_k_norm": gain(ks[9], HEAD_DIM),
        "b_q_norm": gain(ks[10], HEAD_DIM),
        "b_k_norm": gain(ks[11], HEAD_DIM),
        "b_sink": 0.5 * jax.random.normal(ks[12], (DEPTH, B_Q_HEADS), f32),
        "w_proj_a": w(ks[13], (A_OUT, D_MODEL), A_OUT),
        "w_proj_b": w(ks[14], (B_OUT, D_MODEL), B_OUT),
        "w_gate": w(ks[15], (D_MODEL, 2 * D_MODEL), D_MODEL),
        "b_gate": 0.02 * jax.random.normal(ks[16], (DEPTH, 2 * D_MODEL), f32),
        "w_out": w(ks[17], (D_MODEL, D_MODEL), D_MODEL),
        "ffn2_norm": gain(ks[18], D_MODEL),
        "ffn2_w_gate": w(ks[19], (D_MODEL, D_FF), D_MODEL),
        "ffn2_w_up": w(ks[20], (D_MODEL, D_FF), D_MODEL),
        "ffn2_w_down": w(ks[21], (D_FF, D_MODEL), D_FF),
        "final_norm": gain(ks[22], D_MODEL),
    }


def reference(x_prompt, x_sample, ffn1_norm, ffn1_w_gate, ffn1_w_up, ffn1_w_down, mix_norm, w_in,
              a_q_norm, a_k_norm, b_q_norm, b_k_norm, b_sink, w_proj_a, w_proj_b, w_gate, b_gate,
              w_out, ffn2_norm, ffn2_w_gate, ffn2_w_up, ffn2_w_down, final_norm):
    def encoder(x):
        for l in range(DEPTH):
            x = encoder_layer(x, ffn1_norm[l], ffn1_w_gate[l], ffn1_w_up[l], ffn1_w_down[l],
                              mix_norm[l], w_in[l], a_q_norm[l], a_k_norm[l], b_q_norm[l],
                              b_k_norm[l], b_sink[l], w_proj_a[l], w_proj_b[l], w_gate[l],
                              b_gate[l], w_out[l], ffn2_norm[l], ffn2_w_gate[l], ffn2_w_up[l],
                              ffn2_w_down[l], final_norm[l])
        return x

    y_prompt = encoder(x_prompt)
    y_sample = encoder(x_sample)
    return (y_prompt, y_sample)
```

```cpp
#include <hip/hip_runtime.h>
#include <cstdio>
#include <cstdint>

#ifndef MK_ONE_LAUNCH
#define MK_ONE_LAUNCH 1
#endif

#define GAS __attribute__((address_space(1)))
#define LAS __attribute__((address_space(3)))
typedef unsigned short bf16_t;
typedef short bf16x8 __attribute__((ext_vector_type(8)));
typedef short s16x4 __attribute__((ext_vector_type(4)));
typedef float f32x4 __attribute__((ext_vector_type(4)));
typedef float f32x16 __attribute__((ext_vector_type(16)));
typedef unsigned u32x4 __attribute__((ext_vector_type(4)));
typedef unsigned u32x2 __attribute__((ext_vector_type(2)));
typedef float f32x2_t __attribute__((ext_vector_type(2)));
typedef __bf16 bf16x2_t __attribute__((ext_vector_type(2)));

constexpr int DM = 1024, DFF = 2816, NTOK = 49152, NQKV = 3072, NY = 768;
constexpr int T_PROMPT = 8192, T_SAMPLE = 16384, NTOK_PROMPT = 16384;
constexpr float NORM_EPS = 1e-6f;
constexpr float LOG2E = 1.4426950408889634f;
constexpr float QSCALE = 0.125f * LOG2E;

__device__ __forceinline__ unsigned cvtpk(float lo, float hi) { f32x2_t v = {lo, hi}; bf16x2_t b = __builtin_convertvector(v, bf16x2_t); return __builtin_bit_cast(unsigned, b); }
__device__ __forceinline__ float bf_lo(unsigned u) { return __builtin_bit_cast(float, u << 16); }
__device__ __forceinline__ float bf_hi(unsigned u) { return __builtin_bit_cast(float, u & 0xffff0000u); }
__device__ __forceinline__ float fast_exp2(float x) { return __builtin_amdgcn_exp2f(x); }
__device__ __forceinline__ float fast_rcp(float x) { return __builtin_amdgcn_rcpf(x); }
__device__ __forceinline__ float fast_rsq(float x) { return __builtin_amdgcn_rsqf(x); }
__device__ __forceinline__ float sigmoidf_(float a) { return fast_rcp(1.0f + fast_exp2(-LOG2E * a)); }

namespace pg8 {
constexpr int BM = 256, BK = 64, HALF = 128, HTB = HALF * BK * 2, STAGE_BYTES = 8 * HTB, NXCD = 8, WGM = 8;
__host__ __device__ __forceinline__ int lds_byte(int r, int c) { const int st = (r >> 4) * 2 + (c >> 5), rr = r & 15, cc = c & 31, ob = rr * 64 + cc * 2; return st * 1024 + (ob ^ (((ob >> 9) & 1) << 5)); }
__host__ __device__ __forceinline__ void stage_rc(int b, int& R, int& C) { const int st = b / 1024, sb = b % 1024, swz = sb ^ (((sb >> 9) & 1) << 5); R = (st >> 1) * 16 + swz / 64; C = (st & 1) * 32 + (swz % 64) / 2; }

struct Unit { int pm, pn; };
struct Gemm { const bf16_t* A; const bf16_t* Bt; int M, N, K, lda; };

struct StaticOrder {
    int nM, nN, nwg, G, c;
    __device__ void init(int M, int N, int G_, int c_) { nM = M / BM; nN = N / BM; nwg = nM * nN; G = G_; c = c_; }
    __device__ bool next(int i, Unit& u) const {
        const long L = (long)i * G + c; if (L >= nwg) return false;
        int wgid = (int)L; { const int q = nwg / NXCD, r = nwg % NXCD, xcd = wgid % NXCD, off = wgid / NXCD; wgid = (xcd < r ? xcd * (q + 1) : r * (q + 1) + (xcd - r) * q) + off; }
        const int nig = WGM * nN, gid = wgid / nig, fm = gid * WGM, gsz = (nM - fm) < WGM ? (nM - fm) : WGM;
        u.pm = fm + ((wgid % nig) % gsz); u.pn = (wgid % nig) / gsz; return true;
    }
};

template <class Epi>
__device__ __forceinline__ void gemm_phase(LAS unsigned char* lds, const Gemm g, const StaticOrder& S, const Epi& E) {
    const int tid = threadIdx.x, wid = __builtin_amdgcn_readfirstlane(tid >> 6), lane = tid & 63, wr = wid >> 2, wc = wid & 3, fr = lane & 15, fq = lane >> 4;
    const int K = g.K, nt = K / BK, lda = g.lda;
    unsigned voffA[2], voffB[2];
#pragma unroll
    for (int i = 0; i < 2; ++i) { int R, C; stage_rc(tid * 16 + i * 8192, R, C); voffA[i] = (unsigned)(R * lda + C) * 2u; voffB[i] = (unsigned)(R * K + C) * 2u; }
    const size_t kstep = (size_t)(BK * 2);
    const size_t hstepA = (size_t)HALF * lda * 2, hstepB = (size_t)HALF * K * 2;
    const size_t tstepA = 2 * hstepA, tstepB = 2 * hstepB;
    const unsigned ldsw = (unsigned)wid * 1024u;
    const int aoff = lds_byte(wr * 64 + fr, fq * 8), boff = lds_byte(wc * 32 + fr, fq * 8);
#define PG8_SA(b, h) (((b) * 2 + (h)) * HTB)
#define PG8_SB(b, h) ((4 + (b) * 2 + (h)) * HTB)
#define PG8_STAGE(bufoff, gbase, voff) do { _Pragma("unroll") for (int _i = 0; _i < 2; ++_i) \
        __builtin_amdgcn_global_load_lds((const unsigned*)((const char*)(gbase) + (voff)[_i]), (LAS unsigned*)(lds + (bufoff) + ldsw + _i * 8192), 16, 0, 0); } while (0)
#define PG8_LDA(dst, b, h) do { _Pragma("unroll") for (int m = 0; m < 4; ++m) _Pragma("unroll") for (int k = 0; k < 2; ++k) dst[m][k] = *(const LAS bf16x8*)(lds + PG8_SA(b, h) + aoff + m * 2048 + k * 1024); } while (0)
#define PG8_LDB(dst, b, h) do { _Pragma("unroll") for (int n = 0; n < 2; ++n) _Pragma("unroll") for (int k = 0; k < 2; ++k) dst[n][k] = *(const LAS bf16x8*)(lds + PG8_SB(b, h) + boff + n * 2048 + k * 1024); } while (0)
#define PG8_MMA(ai, bj, At, Bt) do { __builtin_amdgcn_s_setprio(1); _Pragma("unroll") for (int m = 0; m < 4; ++m) _Pragma("unroll") for (int n = 0; n < 2; ++n) _Pragma("unroll") for (int k = 0; k < 2; ++k) \
        acc[ai][bj][m][n] = __builtin_amdgcn_mfma_f32_16x16x32_bf16(Bt[n][k], At[m][k], acc[ai][bj][m][n], 0, 0, 0); __builtin_amdgcn_s_setprio(0); } while (0)
#define PG8_WAIT_V(n) asm volatile("s_waitcnt vmcnt(" #n ")" ::: "memory")
#define PG8_WAIT_L(n) asm volatile("s_waitcnt lgkmcnt(" #n ")" ::: "memory")
#define PG8_BAR __builtin_amdgcn_s_barrier()
#define PG8_SCHED __builtin_amdgcn_sched_barrier(0)
    Unit cur, nxt; int ui = 0;
    if (!S.next(0, cur)) return;
    f32x4 acc[2][2][4][2];
#pragma unroll
    for (int a = 0; a < 2; ++a)
#pragma unroll
        for (int b = 0; b < 2; ++b)
#pragma unroll
            for (int m = 0; m < 4; ++m)
#pragma unroll
                for (int n = 0; n < 2; ++n) acc[a][b][m][n] = (f32x4){0.f, 0.f, 0.f, 0.f};
    bf16x8 At[4][2], B0[2][2], B1[2][2];
    const char* cA = (const char*)g.A + (size_t)cur.pm * tstepA; const char* cB = (const char*)g.Bt + (size_t)cur.pn * tstepB;
    PG8_STAGE(PG8_SB(0, 0), cB, voffB); PG8_STAGE(PG8_SB(0, 1), cB + hstepB, voffB); PG8_STAGE(PG8_SA(0, 0), cA, voffA); PG8_STAGE(PG8_SA(0, 1), cA + hstepA, voffA);
    if (wr == 1) PG8_BAR;
    PG8_WAIT_V(2); PG8_BAR;
    PG8_STAGE(PG8_SB(1, 0), cB + kstep, voffB); PG8_STAGE(PG8_SA(1, 0), cA + kstep, voffA); PG8_STAGE(PG8_SB(1, 1), cB + hstepB + kstep, voffB);
    PG8_WAIT_V(6); PG8_BAR;
    for (;;) {
        const bool has_next = S.next(ui + 1, nxt);
        const char* nA = has_next ? (const char*)g.A + (size_t)nxt.pm * tstepA : cA; const char* nB = has_next ? (const char*)g.Bt + (size_t)nxt.pn * tstepB : cB;
        for (int t = 0; t < nt; t += 2) {
            const bool last = (t == nt - 2);
            const char* a1 = cA + (size_t)(t + 1) * kstep;
            const char* a2 = last ? nA : cA + (size_t)(t + 2) * kstep; const char* b2 = last ? nB : cB + (size_t)(t + 2) * kstep;
            const char* a3 = a2 + kstep; const char* b3 = b2 + kstep;
            PG8_LDB(B0, 0, 0); PG8_LDB(B1, 0, 1); PG8_SCHED; PG8_LDA(At, 0, 0); PG8_STAGE(PG8_SA(1, 1), a1 + hstepA, voffA);
            PG8_WAIT_V(8); PG8_WAIT_L(0); PG8_BAR; PG8_MMA(0, 0, At, B0); PG8_MMA(0, 1, At, B1); PG8_BAR; PG8_SCHED;
            PG8_LDA(At, 0, 1); PG8_STAGE(PG8_SB(0, 0), b2, voffB); PG8_STAGE(PG8_SB(0, 1), b2 + hstepB, voffB); PG8_STAGE(PG8_SA(0, 0), a2, voffA);
            PG8_WAIT_V(8); PG8_WAIT_L(0); PG8_BAR; PG8_MMA(1, 0, At, B0); PG8_MMA(1, 1, At, B1); PG8_BAR; PG8_SCHED;
            PG8_LDB(B0, 1, 0); PG8_LDB(B1, 1, 1); PG8_SCHED; PG8_LDA(At, 1, 0); PG8_STAGE(PG8_SA(0, 1), a2 + hstepA, voffA);
            PG8_WAIT_V(8); PG8_WAIT_L(0); PG8_BAR; PG8_MMA(0, 0, At, B0); PG8_MMA(0, 1, At, B1); PG8_BAR; PG8_SCHED;
            PG8_LDA(At, 1, 1); PG8_STAGE(PG8_SB(1, 0), b3, voffB); PG8_STAGE(PG8_SB(1, 1), b3 + hstepB, voffB); PG8_STAGE(PG8_SA(1, 0), a3, voffA);
            PG8_WAIT_V(8); PG8_WAIT_L(0); PG8_BAR; PG8_MMA(1, 0, At, B0); PG8_MMA(1, 1, At, B1); PG8_BAR; PG8_SCHED;
        }
        if (wr == 0) PG8_BAR;
        E(acc, cur, wr, wc, fr, fq, lane);
        if (!has_next) break;
#pragma unroll
        for (int a = 0; a < 2; ++a)
#pragma unroll
            for (int b = 0; b < 2; ++b)
#pragma unroll
                for (int m = 0; m < 4; ++m)
#pragma unroll
                    for (int n = 0; n < 2; ++n) acc[a][b][m][n] = (f32x4){0.f, 0.f, 0.f, 0.f};
        cur = nxt; cA = nA; cB = nB; ++ui;
        if (wr == 1) PG8_BAR;
    }
    PG8_WAIT_V(0);
    PG8_BAR;
#undef PG8_SA
#undef PG8_SB
#undef PG8_STAGE
#undef PG8_LDA
#undef PG8_LDB
#undef PG8_MMA
#undef PG8_WAIT_V
#undef PG8_WAIT_L
#undef PG8_BAR
#undef PG8_SCHED
}

__device__ __forceinline__ void row_rs(const float* ssq, int pm, int wr, int lane, float& r0, float& r1) {
    const f32x4* p0 = (const f32x4*)(ssq + (size_t)(pm * BM + wr * 64 + lane) * 16); const f32x4* p1 = p0 + HALF * 4;
    const f32x4 a0 = p0[0], a1 = p0[1], a2 = p0[2], a3 = p0[3], b0 = p1[0], b1 = p1[1], b2 = p1[2], b3 = p1[3];
    const f32x4 sa = (a0 + a1) + (a2 + a3), sb = (b0 + b1) + (b2 + b3);
    r0 = fast_rsq(((sa[0] + sa[1]) + (sa[2] + sa[3])) * (1.0f / DM) + NORM_EPS);
    r1 = fast_rsq(((sb[0] + sb[1]) + (sb[2] + sb[3])) * (1.0f / DM) + NORM_EPS);
}

struct EpiSwiGLU {
    bf16_t* O; const float* ssq;
    __device__ __forceinline__ void operator()(const f32x4 (&acc)[2][2][4][2], const Unit& u, int wr, int wc, int fr, int fq, int lane) const {
        float r0, r1; row_rs(ssq, u.pm, wr, lane, r0, r1);
        const int col0 = u.pn * 128 + wc * 32 + fq * 8;
#pragma unroll
        for (int ai = 0; ai < 2; ++ai)
#pragma unroll
            for (int m = 0; m < 4; ++m) {
                const float rr = __shfl(ai ? r1 : r0, 16 * m + fr);
                const size_t row = (size_t)(u.pm * BM + ai * HALF + wr * 64 + m * 16 + fr);
                float o[8];
#pragma unroll
                for (int bj = 0; bj < 2; ++bj)
#pragma unroll
                    for (int e = 0; e < 4; ++e) { const float gt = acc[ai][bj][m][0][e] * rr, up = acc[ai][bj][m][1][e] * rr;
                        o[bj * 4 + e] = gt * up * fast_rcp(1.0f + fast_exp2(-LOG2E * gt)); }
                u32x4 w; w.x = cvtpk(o[0], o[1]); w.y = cvtpk(o[2], o[3]); w.z = cvtpk(o[4], o[5]); w.w = cvtpk(o[6], o[7]);
                *(u32x4*)(O + row * DFF + col0) = w;
            }
    }
};

template <bool WRITE_HB> struct EpiRes {
    const float* res0; const float* res1; float* out; bf16_t* hb; float* ssq; float scale;
    __device__ __forceinline__ void operator()(const f32x4 (&acc)[2][2][4][2], const Unit& u, int wr, int wc, int fr, int fq, int lane) const {
        const float* rb = (u.pm < NTOK_PROMPT / BM) ? res0 : res1;
        const int col0 = u.pn * BM + wc * 32 + 4 * fq;
#pragma unroll
        for (int ai = 0; ai < 2; ++ai)
#pragma unroll
            for (int m = 0; m < 4; ++m) {
                const size_t row = (size_t)(u.pm * BM + ai * HALF + wr * 64 + m * 16 + fr); const size_t off = row * DM + col0;
                f32x4 bs[2][2];
#pragma unroll
                for (int bj = 0; bj < 2; ++bj)
#pragma unroll
                    for (int n = 0; n < 2; ++n) bs[bj][n] = *(const f32x4*)(rb + off + bj * HALF + n * 16);
                float ss = 0.f;
#pragma unroll
                for (int bj = 0; bj < 2; ++bj)
#pragma unroll
                    for (int n = 0; n < 2; ++n) { const f32x4 v = bs[bj][n] + acc[ai][bj][m][n] * scale;
                        *(f32x4*)(out + off + bj * HALF + n * 16) = v; ss += (v[0] * v[0] + v[1] * v[1]) + (v[2] * v[2] + v[3] * v[3]);
                        if (WRITE_HB) { u32x2 w; w.x = cvtpk(v[0], v[1]); w.y = cvtpk(v[2], v[3]); *(u32x2*)(hb + off + bj * HALF + n * 16) = w; } }
                ss += __shfl_xor(ss, 16); ss += __shfl_xor(ss, 32);
                if (fq == 0) ssq[row * 16 + u.pn * 4 + wc] = ss;
            }
    }
};

struct EpiQKV {
    bf16_t* O; const float* ssq; const float *gaq, *gak, *gbq, *gbk;
    __device__ __forceinline__ void operator()(const f32x4 (&acc)[2][2][4][2], const Unit& u, int wr, int wc, int fr, int fq, int lane) const {
        float r0, r1; row_rs(ssq, u.pm, wr, lane, r0, r1);
        const float* gp = nullptr; float qs = 1.0f;
        if (u.pn < 3) { gp = gaq; qs = QSCALE; } else if (u.pn < 6) { gp = gak; } else if (u.pn < 9) { gp = nullptr; } else if (u.pn < 11) { gp = gbq; qs = QSCALE; } else if (wc < 2) { gp = gbk; }
        float gn[16];
#pragma unroll
        for (int i = 0; i < 16; ++i) gn[i] = 1.0f;
        if (gp) {
#pragma unroll
            for (int i = 0; i < 4; ++i) { const f32x4 t = *(const f32x4*)(gp + 16 * fq + 4 * i); gn[4 * i] = t[0] * qs; gn[4 * i + 1] = t[1] * qs; gn[4 * i + 2] = t[2] * qs; gn[4 * i + 3] = t[3] * qs; }
        }
        const int col0 = u.pn * BM + wc * 64 + fq * 16;
#pragma unroll
        for (int ai = 0; ai < 2; ++ai)
#pragma unroll
            for (int m = 0; m < 4; ++m) {
                const float rr = __shfl(ai ? r1 : r0, 16 * m + fr);
                const size_t row = (size_t)(u.pm * BM + ai * HALF + wr * 64 + m * 16 + fr);
                float v[16]; float ss = 0.f;
#pragma unroll
                for (int bj = 0; bj < 2; ++bj)
#pragma unroll
                    for (int n = 0; n < 2; ++n)
#pragma unroll
                        for (int e = 0; e < 4; ++e) { const float x = acc[ai][bj][m][n][e] * rr; v[bj * 8 + n * 4 + e] = x; ss += x * x; }
                ss += __shfl_xor(ss, 16); ss += __shfl_xor(ss, 32);
                const float hr = gp ? fast_rsq(ss * (1.0f / 64.0f) + NORM_EPS) : 1.0f;
#pragma unroll
                for (int i = 0; i < 16; ++i) v[i] = v[i] * hr * gn[i];
                u32x4 w0, w1; w0.x = cvtpk(v[0], v[1]); w0.y = cvtpk(v[2], v[3]); w0.z = cvtpk(v[4], v[5]); w0.w = cvtpk(v[6], v[7]);
                w1.x = cvtpk(v[8], v[9]); w1.y = cvtpk(v[10], v[11]); w1.z = cvtpk(v[12], v[13]); w1.w = cvtpk(v[14], v[15]);
                bf16_t* p = O + row * NQKV + col0; *(u32x4*)p = w0; *(u32x4*)(p + 8) = w1;
            }
    }
};

struct EpiPlain {
    bf16_t* O; int ldc;
    __device__ __forceinline__ void operator()(const f32x4 (&acc)[2][2][4][2], const Unit& u, int wr, int wc, int fr, int fq, int lane) const {
        const int col0 = u.pn * BM + wc * 32 + fq * 8;
#pragma unroll
        for (int ai = 0; ai < 2; ++ai)
#pragma unroll
            for (int m = 0; m < 4; ++m) {
                const size_t row = (size_t)(u.pm * BM + ai * HALF + wr * 64 + m * 16 + fr);
#pragma unroll
                for (int bj = 0; bj < 2; ++bj) { const f32x4 v0 = acc[ai][bj][m][0], v1 = acc[ai][bj][m][1];
                    u32x4 w; w.x = cvtpk(v0[0], v0[1]); w.y = cvtpk(v0[2], v0[3]); w.z = cvtpk(v1[0], v1[1]); w.w = cvtpk(v1[2], v1[3]);
                    *(u32x4*)(O + row * ldc + col0 + bj * HALF) = w; }
            }
    }
};

struct EpiGate {
    bf16_t* O; const float* ssq; const float* bgate; const bf16_t* PA; const bf16_t* PB;
    __device__ __forceinline__ void operator()(const f32x4 (&acc)[2][2][4][2], const Unit& u, int wr, int wc, int fr, int fq, int lane) const {
        float r0, r1; row_rs(ssq, u.pm, wr, lane, r0, r1);
        const int col0 = u.pn * 128 + wc * 32 + fq * 8;
        float ba[8], bb[8];
        { const f32x4 t0 = *(const f32x4*)(bgate + col0), t1 = *(const f32x4*)(bgate + col0 + 4), t2 = *(const f32x4*)(bgate + DM + col0), t3 = *(const f32x4*)(bgate + DM + col0 + 4);
#pragma unroll
          for (int e = 0; e < 4; ++e) { ba[e] = t0[e]; ba[4 + e] = t1[e]; bb[e] = t2[e]; bb[4 + e] = t3[e]; } }
#pragma unroll
        for (int ai = 0; ai < 2; ++ai)
#pragma unroll
            for (int m = 0; m < 4; ++m) {
                const float rr = __shfl(ai ? r1 : r0, 16 * m + fr);
                const size_t row = (size_t)(u.pm * BM + ai * HALF + wr * 64 + m * 16 + fr);
                const u32x4 pa = *(const u32x4*)(PA + row * DM + col0), pb = *(const u32x4*)(PB + row * DM + col0);
                float o[8];
#pragma unroll
                for (int bj = 0; bj < 2; ++bj)
#pragma unroll
                    for (int e = 0; e < 4; ++e) { const int i = bj * 4 + e;
                        const float ga = sigmoidf_(acc[ai][bj][m][0][e] * rr + ba[i]), gb = sigmoidf_(acc[ai][bj][m][1][e] * rr + bb[i]);
                        const unsigned wa = pa[i >> 1], wb = pb[i >> 1];
                        const float xa = (i & 1) ? bf_hi(wa) : bf_lo(wa), xb = (i & 1) ? bf_hi(wb) : bf_lo(wb);
                        o[i] = ga * xa + gb * xb; }
                u32x4 w; w.x = cvtpk(o[0], o[1]); w.y = cvtpk(o[2], o[3]); w.z = cvtpk(o[4], o[5]); w.w = cvtpk(o[6], o[7]);
                *(u32x4*)(O + row * DM + col0) = w;
            }
    }
};
}

namespace att {
constexpr int KPL = 6144 + 16, VPL = 24576 + 64;
constexpr int OFF_K = 0, OFF_V = 8 * KPL, OFF_WS = OFF_V + 2 * VPL, OFF_OST = OFF_WS + 8 * 256, LDS_BYTES = OFF_OST + 8 * 4096;
__device__ __forceinline__ int crow(int r, int hi) { return (r & 3) + 8 * (r >> 2) + 4 * hi; }
__device__ __forceinline__ s16x4 vtr(const LAS unsigned char* p) { return __builtin_bit_cast(s16x4, __builtin_amdgcn_ds_read_tr16_b64_v4i16((LAS s16x4*)p)); }

template <int NIT>
__device__ __forceinline__ void stage_kv(LAS unsigned char* lds, const bf16_t* Kg, const bf16_t* Vg, long rstride, int row_lo, int row_hi, int tid) {
    u32x4 kv[NIT], vv[NIT];
#pragma unroll
    for (int it = 0; it < NIT; ++it) { const int q = tid + it * 512, row = q >> 3, c = q & 7;
        if (row >= row_lo && row < row_hi) { kv[it] = *(const u32x4*)(Kg + (long)row * rstride + c * 8); vv[it] = *(const u32x4*)(Vg + (long)row * rstride + c * 8); } }
#pragma unroll
    for (int it = 0; it < NIT; ++it) { const int q = tid + it * 512, row = q >> 3, c = q & 7;
        if (row >= row_lo && row < row_hi) { *(LAS u32x4*)(lds + OFF_K + c * KPL + row * 16) = kv[it]; *(LAS u32x4*)(lds + OFF_V + (c >> 2) * VPL + row * 64 + (c & 3) * 16) = vv[it]; } }
}

template <int HW>
__device__ __forceinline__ void attn_task(LAS unsigned char* lds, const bf16_t* Qg, long qstride, int jlo, int jhi, int qoff, float nslope2, float nshift, f32x16& o0, f32x16& o1, float& lsum) {
    const int lane = threadIdx.x & 63, r32 = lane & 31, hi = lane >> 5;
    bf16x8 qr[4];
#pragma unroll
    for (int d0 = 0; d0 < 4; ++d0) qr[d0] = *(const bf16x8*)(Qg + (long)r32 * qstride + d0 * 16 + hi * 8);
    const LAS unsigned char* kp = lds + OFF_K + hi * KPL + r32 * 16;
    const LAS unsigned char* vp = lds + OFF_V + ((lane >> 4) & 1) * 32 + (lane & 3) * 8 + (4 * hi + ((lane & 15) >> 2)) * 64;
    f32x16 negs;
#pragma unroll
    for (int r = 0; r < 16; ++r) negs[r] = nshift;
    f32x16 oa = {}, ob = {}; float l = 0.f;
    for (int j = jlo; j <= jhi; ++j) {
        const LAS unsigned char* kt = kp + j * 1024;
        f32x16 p0 = negs, p1 = negs;
#pragma unroll
        for (int d0 = 0; d0 < 4; ++d0) { const bf16x8 b0 = *(const LAS bf16x8*)(kt + 2 * d0 * KPL), b1 = *(const LAS bf16x8*)(kt + 2 * d0 * KPL + 512);
            p0 = __builtin_amdgcn_mfma_f32_32x32x16_bf16(b0, qr[d0], p0, 0, 0, 0); p1 = __builtin_amdgcn_mfma_f32_32x32x16_bf16(b1, qr[d0], p1, 0, 0, 0); }
        const float basef = (float)(qoff + r32 - 64 * j - 4 * hi);
        float s = 0.f;
#pragma unroll
        for (int r = 0; r < 16; ++r) { const float cc = (float)((r & 3) + 8 * (r >> 2));
            const float a0 = __builtin_fabsf(basef - cc), a1 = __builtin_fabsf(basef - cc - 32.0f);
            float v0 = __builtin_fmaf(a0, nslope2, p0[r]), v1 = __builtin_fmaf(a1, nslope2, p1[r]);
            v0 = (a0 <= (float)HW) ? v0 : -INFINITY; v1 = (a1 <= (float)HW) ? v1 : -INFINITY;
            p0[r] = fast_exp2(v0); p1[r] = fast_exp2(v1); s += p0[r] + p1[r]; }
        l += s;
        u32x4 pw[4];
#pragma unroll
        for (int i = 0; i < 4; ++i) { pw[0][i] = cvtpk(p0[2 * i], p0[2 * i + 1]); pw[1][i] = cvtpk(p0[8 + 2 * i], p0[9 + 2 * i]); pw[2][i] = cvtpk(p1[2 * i], p1[2 * i + 1]); pw[3][i] = cvtpk(p1[8 + 2 * i], p1[9 + 2 * i]); }
        const LAS unsigned char* vt = vp + j * 4096;
#pragma unroll
        for (int ks = 0; ks < 4; ++ks) {
            const s16x4 lo0 = vtr(vt + ks * 1024), hi0 = vtr(vt + ks * 1024 + 512), lo1 = vtr(vt + VPL + ks * 1024), hi1 = vtr(vt + VPL + ks * 1024 + 512);
            const bf16x8 pa = __builtin_bit_cast(bf16x8, pw[ks]);
            const bf16x8 v0 = (bf16x8){lo0[0], lo0[1], lo0[2], lo0[3], hi0[0], hi0[1], hi0[2], hi0[3]}, v1 = (bf16x8){lo1[0], lo1[1], lo1[2], lo1[3], hi1[0], hi1[1], hi1[2], hi1[3]};
            oa = __builtin_amdgcn_mfma_f32_32x32x16_bf16(pa, v0, oa, 0, 0, 0); ob = __builtin_amdgcn_mfma_f32_32x32x16_bf16(pa, v1, ob, 0, 0, 0);
        }
    }
    l += __shfl_xor(l, 32);
    o0 = oa; o1 = ob; lsum = l;
}

__device__ __forceinline__ void attn_store(LAS unsigned char* lds, const f32x16& o0, const f32x16& o1, float l, float extra, bf16_t* Og, long ostride, int wid) {
    const int lane = threadIdx.x & 63, r32 = lane & 31, hi = lane >> 5;
    LAS float* wsf = (LAS float*)(lds + OFF_WS + wid * 256);
    if (hi == 0) wsf[r32] = fast_rcp(l + extra);
    LAS bf16_t* stg = (LAS bf16_t*)(lds + OFF_OST + wid * 4096);
#pragma unroll
    for (int r = 0; r < 16; ++r) { const int orow = crow(r, hi); const float rl = wsf[orow];
        const unsigned a = cvtpk(o0[r] * rl, 0.f), b = cvtpk(o1[r] * rl, 0.f);
        stg[orow * 64 + r32] = (bf16_t)(a & 0xffffu); stg[orow * 64 + 32 + r32] = (bf16_t)(b & 0xffffu); }
#pragma unroll
    for (int i = 0; i < 4; ++i) { const int row = i * 8 + (lane >> 3), ch = lane & 7; const u32x4 v = *(const LAS u32x4*)(stg + row * 64 + ch * 8); *(u32x4*)(Og + (long)row * ostride + ch * 8) = v; }
}
}

constexpr int NWAVES = 8;
constexpr int NPHASE = 12;
constexpr size_t MiB = 1u << 20;
constexpr size_t WS_CTL = 0, CTL_ZERO_BYTES = 1 * MiB;
constexpr size_t WS_SSQ0 = 1 * MiB, WS_SSQ1 = 4 * MiB, WS_SSQ2 = 7 * MiB, WS_SSQ3 = 10 * MiB;
constexpr size_t WS_LTAB = 13 * MiB;
constexpr size_t WS_WIN = 16 * MiB, WS_WGATE = 22 * MiB, WS_WPA = 26 * MiB, WS_WPB = 27 * MiB, WS_WOUT = 28 * MiB, WS_W2GU = 30 * MiB, WS_W2D = 41 * MiB;
constexpr size_t WS_HB = 47 * MiB;
constexpr size_t WS_W1GU = 143 * MiB, WS_W1D = 154 * MiB;
constexpr size_t WS_Y = 143 * MiB;
constexpr size_t WS_ACT = 160 * MiB;
constexpr size_t WS_QKV = 215 * MiB;
constexpr size_t WS_PA = 215 * MiB, WS_PB = 311 * MiB, WS_M = 407 * MiB;
constexpr size_t WS_END = 503 * MiB;
constexpr int CW_BAR = 4096;

constexpr int RING_BYTES = 134144;
constexpr int LDSCTL_OFF = RING_BYTES, MISC_OFF = LDSCTL_OFF + 320;
constexpr int LDS_BYTES = 147456;
static_assert(att::LDS_BYTES <= RING_BYTES && pg8::STAGE_BYTES <= RING_BYTES && MISC_OFF + 128 <= LDS_BYTES, "LDS map");

typedef GAS unsigned gu32;
#define RLX_AGENT __ATOMIC_RELAXED, __HIP_MEMORY_SCOPE_AGENT
#define LDS_WAIT() asm volatile("s_waitcnt lgkmcnt(0)" ::: "memory")

#define XB_TMO      128
#define XB_XCNT(j)  (256  + 64 * (j))
#define XB_XSUB(j)  (1280 + 64 * (j))
#define XB_XGEN(j)  (2304 + 64 * (j))
#define XB_TOP      3328
#define XB_TOPGEN   3392
#define XCD_BAR_WORDS 3456
#define XB_SPIN_CAP (1u << 18)
__device__ __forceinline__ unsigned xb_ld(unsigned* p)              { return __hip_atomic_load(p, __ATOMIC_RELAXED, __HIP_MEMORY_SCOPE_AGENT); }
__device__ __forceinline__ unsigned xb_add(unsigned* p, unsigned v) { return __hip_atomic_fetch_add(p, v, __ATOMIC_RELAXED, __HIP_MEMORY_SCOPE_AGENT); }
__device__ __forceinline__ unsigned xb_xcc_id() { return (unsigned)__builtin_amdgcn_s_getreg((3 << 11) | 20) & 0xFu; }
#define XB_SPIN(cond, bar) do { unsigned _sp = 0; while (cond) { __builtin_amdgcn_s_sleep(1); \
    if ((++_sp & 255u) == 0u) { if (xb_ld(&(bar)[XB_TMO])) break; if (_sp > XB_SPIN_CAP) { atomicAdd(&(bar)[XB_TMO], 1u); break; } } } } while (0)
struct XcdBarrier { unsigned* bar; unsigned x; volatile LAS unsigned* st; };
__device__ __forceinline__ XcdBarrier xcd_barrier_post(unsigned* bar, volatile LAS unsigned* st) {
    XcdBarrier b; b.bar = bar; b.x = xb_xcc_id(); b.st = st;
    if (threadIdx.x == 0) (void)xb_add(&bar[XB_XCNT(b.x)], 1u);
    return b;
}
__device__ __forceinline__ void xcd_barrier_complete(unsigned* bar, unsigned x, unsigned& nloc, unsigned& nx) {
    const unsigned G = gridDim.x * gridDim.y * gridDim.z;
    unsigned sum, cnt, mine, sp = 0u;
    for (;;) {
        sum = 0u; cnt = 0u; mine = 0u;
#pragma unroll
        for (unsigned j = 0; j < 16; ++j) { const unsigned c = xb_ld(&bar[XB_XCNT(j)]); sum += c; cnt += (c > 0u) ? 1u : 0u; mine = (j == x) ? c : mine; }
        if (sum == G) break;
        __builtin_amdgcn_s_sleep(1);
        if ((++sp & 255u) == 0u) { if (xb_ld(&bar[XB_TMO])) break; if (sp > XB_SPIN_CAP) { atomicAdd(&bar[XB_TMO], 1u); break; } }
    }
    nloc = mine > 0u ? mine : 1u; nx = cnt > 0u ? cnt : 1u;
}
__device__ __forceinline__ void xcd_barrier(const XcdBarrier& b) {
    asm volatile("s_waitcnt vmcnt(0)" ::: "memory");
    __syncthreads();
    if (threadIdx.x == 0) {
        unsigned* bar = b.bar;
        __builtin_amdgcn_s_waitcnt(0);
        unsigned nloc = b.st[0], nx = b.st[1];
        if (nloc == 0u) { xcd_barrier_complete(bar, b.x, nloc, nx); b.st[0] = nloc; b.st[1] = nx; }
        const unsigned old = xb_add(&bar[XB_XSUB(b.x)], 1u);
        const unsigned gen = old / nloc;
        if (old + 1u == (gen + 1u) * nloc) {
            __builtin_amdgcn_fence(__ATOMIC_RELEASE, "agent");
            asm volatile("s_waitcnt vmcnt(0)" ::: "memory");
            const unsigned og = xb_add(&bar[XB_TOP], 1u);
            const unsigned tg = og / nx;
            if (og + 1u == (tg + 1u) * nx) xb_add(&bar[XB_TOPGEN], 1u);
            else XB_SPIN(xb_ld(&bar[XB_TOPGEN]) == tg, bar);
            __builtin_amdgcn_fence(__ATOMIC_ACQUIRE, "agent");
            xb_add(&bar[XB_XGEN(b.x)], 1u);
            asm volatile("s_waitcnt vmcnt(0)" ::: "memory");
        } else {
            XB_SPIN(xb_ld(&bar[XB_XGEN(b.x)]) == gen, bar);
            __builtin_amdgcn_fence(__ATOMIC_ACQUIRE, "agent");
            asm volatile("s_waitcnt vmcnt(0)" ::: "memory");
        }
    }
    __syncthreads();
}

__device__ __forceinline__ float wave_sum(float v) {
#pragma unroll
    for (int o = 1; o < 64; o <<= 1) v += __shfl_xor(v, o);
    return v;
}
__device__ __forceinline__ float wave_max(float v) {
#pragma unroll
    for (int o = 1; o < 64; o <<= 1) v = __builtin_fmaxf(v, __shfl_xor(v, o));
    return v;
}

__device__ __forceinline__ int map_gu(int sel, int col) { const int pn = col >> 7, c = col & 127, wc = c >> 5, fq = (c >> 3) & 3, bj = (c >> 2) & 1, e = c & 3; return 256 * pn + 128 * bj + 32 * wc + 16 * sel + 4 * fq + e; }
__device__ __forceinline__ int map_head(int col) { const int pn = col >> 8, c = col & 255, wc = c >> 6, ch = c & 63, fq = ch >> 4, bj = (ch >> 3) & 1, n = (ch >> 2) & 1, e = ch & 3; return 256 * pn + 128 * bj + 32 * wc + 16 * n + 4 * fq + e; }
__device__ __forceinline__ int map_p8(int col) { const int pn = col >> 8, c = col & 255, bj = c >> 7, wc = (c >> 5) & 3, fq = (c >> 3) & 3, n = (c >> 2) & 1, e = c & 3; return 256 * pn + 128 * bj + 32 * wc + 16 * n + 4 * fq + e; }
template <int MAPK>
__device__ __forceinline__ void transpose_item(const float* W, int K, int N, bf16_t* WT, const float* gain, LAS float* scr, int item, int lane) {
    const int nblk = N / 32, kb = item / nblk, nb = item % nblk, k0 = 64 * kb, n0 = 32 * nb;
#pragma unroll 8
    for (int i = 0; i < 32; ++i) { const int kk = 2 * i + (lane >> 5); const float gsc = gain ? gain[k0 + kk] : 1.0f; scr[kk * 33 + (lane & 31)] = W[(size_t)(k0 + kk) * N + n0 + (lane & 31)] * gsc; }
    LDS_WAIT(); asm volatile("" ::: "memory");
    const int c = lane & 7;
#pragma unroll
    for (int j = 0; j < 4; ++j) { const int n = (lane >> 3) + 8 * j; const LAS float* s = scr + (8 * c) * 33 + n;
        u32x4 o; o.x = cvtpk(s[0 * 33], s[1 * 33]); o.y = cvtpk(s[2 * 33], s[3 * 33]); o.z = cvtpk(s[4 * 33], s[5 * 33]); o.w = cvtpk(s[6 * 33], s[7 * 33]);
        const int col = n0 + n;
        const int row = MAPK == 0 ? col : MAPK == 1 ? map_gu(0, col) : MAPK == 2 ? map_gu(1, col) : MAPK == 3 ? map_head(col) : map_p8(col);
        *(u32x4*)(WT + (size_t)row * K + k0 + 8 * c) = o; }
    LDS_WAIT(); asm volatile("" ::: "memory");
}

struct Args { const float* in[23]; float* out; unsigned char* ws; int ph_lo, ph_hi; };

__global__ void __launch_bounds__(NWAVES * 64, 2) enc_fwd(Args args) {
    extern __shared__ __attribute__((aligned(16))) unsigned char lds_raw[];
    LAS unsigned char* lds = (LAS unsigned char*)lds_raw;
    volatile LAS unsigned* MISC = (volatile LAS unsigned*)(lds + MISC_OFF);
    const int tid = threadIdx.x, lane = tid & 63, wave = __builtin_amdgcn_readfirstlane(tid >> 6);
    const int G = gridDim.x, bx = blockIdx.x;
    const int vcu = (G % 8 == 0) ? (bx % 8) * (G / 8) + bx / 8 : bx;
    unsigned char* ws = args.ws;
    gu32* ctl = (gu32*)(ws + WS_CTL);
    const float* x_prompt = args.in[0]; const float* x_sample = args.in[1];
    const float* ffn1_norm = args.in[2]; const float* ffn1_wg = args.in[3]; const float* ffn1_wu = args.in[4]; const float* ffn1_wd = args.in[5];
    const float* mix_norm = args.in[6]; const float* w_in = args.in[7];
    const float* a_q_norm = args.in[8]; const float* a_k_norm = args.in[9]; const float* b_q_norm = args.in[10]; const float* b_k_norm = args.in[11]; const float* b_sink = args.in[12];
    const float* w_proj_a = args.in[13]; const float* w_proj_b = args.in[14]; const float* w_gate = args.in[15]; const float* b_gate = args.in[16]; const float* w_out = args.in[17];
    const float* ffn2_norm = args.in[18]; const float* ffn2_wg = args.in[19]; const float* ffn2_wu = args.in[20]; const float* ffn2_wd = args.in[21]; const float* final_norm = args.in[22];
    float* out = args.out;
    float* ssq0 = (float*)(ws + WS_SSQ0); float* ssq1 = (float*)(ws + WS_SSQ1); float* ssq2 = (float*)(ws + WS_SSQ2); float* ssq3 = (float*)(ws + WS_SSQ3);
    float* ltab = (float*)(ws + WS_LTAB);
    bf16_t* Win_t = (bf16_t*)(ws + WS_WIN); bf16_t* Wgate_t = (bf16_t*)(ws + WS_WGATE); bf16_t* Wpa_t = (bf16_t*)(ws + WS_WPA); bf16_t* Wpb_t = (bf16_t*)(ws + WS_WPB); bf16_t* Wout_t = (bf16_t*)(ws + WS_WOUT);
    bf16_t* W1gu_t = (bf16_t*)(ws + WS_W1GU); bf16_t* W1d_t = (bf16_t*)(ws + WS_W1D); bf16_t* W2gu_t = (bf16_t*)(ws + WS_W2GU); bf16_t* W2d_t = (bf16_t*)(ws + WS_W2D);
    bf16_t* HB = (bf16_t*)(ws + WS_HB); bf16_t* ACT = (bf16_t*)(ws + WS_ACT); bf16_t* QKV = (bf16_t*)(ws + WS_QKV); bf16_t* Y = (bf16_t*)(ws + WS_Y);
    bf16_t* PA = (bf16_t*)(ws + WS_PA); bf16_t* PB = (bf16_t*)(ws + WS_PB); bf16_t* MB = (bf16_t*)(ws + WS_M);

    for (int u = tid; u < (LDS_BYTES - LDSCTL_OFF) / 4; u += NWAVES * 64) ((LAS unsigned*)(lds + LDSCTL_OFF))[u] = 0u;
    __syncthreads();
#if MK_ONE_LAUNCH
    XcdBarrier bar = xcd_barrier_post((unsigned*)(ctl + CW_BAR), MISC + 8);
#define GRID_BAR() xcd_barrier(bar)
#else
#define GRID_BAR() do { } while (0)
#endif
    const int lo = args.ph_lo, hi = args.ph_hi;
#define IN(k) (lo <= (k) && (k) < hi)
#define BOTH(k) (IN(k) && IN((k) + 1))
    const int gw = vcu * NWAVES + wave, NGW = G * NWAVES;

    if (IN(0)) {
        LAS float* scr = (LAS float*)(lds + wave * 16384);
        constexpr int I_GU = (DM / 64) * (DFF / 32), I_D = (DFF / 64) * (DM / 32), I_IN = (DM / 64) * (NQKV / 32), I_GT = (DM / 64) * (2 * DM / 32), I_PA = (256 / 64) * (DM / 32), I_PB = (512 / 64) * (DM / 32), I_O = (DM / 64) * (DM / 32);
        constexpr int NITEMS = 4 * I_GU + 2 * I_D + I_IN + I_GT + I_PA + I_PB + I_O;
        for (int it = gw; it < NITEMS; it += NGW) {
            int r = it;
            if (r < I_GU) { transpose_item<1>(ffn1_wg, DM, DFF, W1gu_t, ffn1_norm, scr, r, lane); continue; } r -= I_GU;
            if (r < I_GU) { transpose_item<2>(ffn1_wu, DM, DFF, W1gu_t, ffn1_norm, scr, r, lane); continue; } r -= I_GU;
            if (r < I_D)  { transpose_item<0>(ffn1_wd, DFF, DM, W1d_t, nullptr, scr, r, lane); continue; } r -= I_D;
            if (r < I_IN) { transpose_item<3>(w_in, DM, NQKV, Win_t, mix_norm, scr, r, lane); continue; } r -= I_IN;
            if (r < I_GT) {
                const int nblk = 2 * DM / 32, nb = r % nblk;
                if (nb < DM / 32) transpose_item<1>(w_gate, DM, 2 * DM, Wgate_t, mix_norm, scr, r, lane);
                else {
                    const int kb = r / nblk, k0 = 64 * kb, n0 = 32 * nb;
#pragma unroll 8
                    for (int i = 0; i < 32; ++i) { const int kk = 2 * i + (lane >> 5); scr[kk * 33 + (lane & 31)] = w_gate[(size_t)(k0 + kk) * (2 * DM) + n0 + (lane & 31)] * mix_norm[k0 + kk]; }
                    LDS_WAIT(); asm volatile("" ::: "memory");
                    const int c = lane & 7;
#pragma unroll
                    for (int j = 0; j < 4; ++j) { const int n = (lane >> 3) + 8 * j; const LAS float* s = scr + (8 * c) * 33 + n;
                        u32x4 o; o.x = cvtpk(s[0 * 33], s[1 * 33]); o.y = cvtpk(s[2 * 33], s[3 * 33]); o.z = cvtpk(s[4 * 33], s[5 * 33]); o.w = cvtpk(s[6 * 33], s[7 * 33]);
                        const int row = map_gu(1, n0 + n - DM);
                        *(u32x4*)(Wgate_t + (size_t)row * DM + k0 + 8 * c) = o; }
                    LDS_WAIT(); asm volatile("" ::: "memory");
                }
                continue; } r -= I_GT;
            if (r < I_PA) { transpose_item<4>(w_proj_a, 256, DM, Wpa_t, nullptr, scr, r, lane); continue; } r -= I_PA;
            if (r < I_PB) { transpose_item<4>(w_proj_b, 512, DM, Wpb_t, nullptr, scr, r, lane); continue; } r -= I_PB;
            if (r < I_O)  { transpose_item<0>(w_out, DM, DM, Wout_t, nullptr, scr, r, lane); continue; } r -= I_O;
            if (r < I_GU) { transpose_item<1>(ffn2_wg, DM, DFF, W2gu_t, ffn2_norm, scr, r, lane); continue; } r -= I_GU;
            if (r < I_GU) { transpose_item<2>(ffn2_wu, DM, DFF, W2gu_t, ffn2_norm, scr, r, lane); continue; } r -= I_GU;
            transpose_item<0>(ffn2_wd, DFF, DM, W2d_t, nullptr, scr, r, lane);
        }
        for (int m = gw; m < NTOK; m += NGW) {
            const float* xrow = (m < NTOK_PROMPT) ? x_prompt + (size_t)m * DM : x_sample + (size_t)(m - NTOK_PROMPT) * DM;
            const f32x4* xr = (const f32x4*)xrow + lane;
            f32x4 v[4]; float s = 0.f;
#pragma unroll
            for (int j = 0; j < 4; ++j) { v[j] = xr[64 * j]; s += (v[j][0] * v[j][0] + v[j][1] * v[j][1]) + (v[j][2] * v[j][2] + v[j][3] * v[j][3]); }
            s = wave_sum(s);
            u32x2* o8 = (u32x2*)(HB + (size_t)m * DM) + lane;
#pragma unroll
            for (int j = 0; j < 4; ++j) { u32x2 w; w.x = cvtpk(v[j][0], v[j][1]); w.y = cvtpk(v[j][2], v[j][3]); o8[64 * j] = w; }
            if (lane < 16) ssq0[(size_t)m * 16 + lane] = (lane == 0) ? s : 0.f;
        }
        if (BOTH(0)) GRID_BAR();
    }
    if (IN(1)) {
        pg8::Gemm g{HB, W1gu_t, NTOK, 2 * DFF, DM, DM}; pg8::StaticOrder S; S.init(NTOK, 2 * DFF, G, bx);
        pg8::EpiSwiGLU E{ACT, ssq0};
        pg8::gemm_phase(lds, g, S, E);
        if (BOTH(1)) GRID_BAR();
    }
    if (IN(2)) {
        pg8::Gemm g{ACT, W1d_t, NTOK, DM, DFF, DFF}; pg8::StaticOrder S; S.init(NTOK, DM, G, bx);
        pg8::EpiRes<true> E{x_prompt, x_sample - (size_t)NTOK_PROMPT * DM, out, HB, ssq1, 0.5f};
        pg8::gemm_phase(lds, g, S, E);
        if (BOTH(2)) GRID_BAR();
    }
    if (IN(3)) {
        pg8::Gemm g{HB, Win_t, NTOK, NQKV, DM, DM}; pg8::StaticOrder S; S.init(NTOK, NQKV, G, bx);
        pg8::EpiQKV E{QKV, ssq1, a_q_norm, a_k_norm, b_q_norm, b_k_norm};
        pg8::gemm_phase(lds, g, S, E);
        if (BOTH(3)) GRID_BAR();
    }
    if (IN(4)) {
        const float mqa = wave_max(__builtin_fabsf(a_q_norm[lane])), mka = wave_max(__builtin_fabsf(a_k_norm[lane]));
        const float mqb = wave_max(__builtin_fabsf(b_q_norm[lane])), mkb = wave_max(__builtin_fabsf(b_k_norm[lane]));
        const float shiftA = 64.0f * QSCALE * mqa * mka, shiftB = 64.0f * QSCALE * mqb * mkb;
        for (int ua = bx; ua < (NTOK / 256) * 12; ua += G) {
            const int head = ua % 12, chunk = ua / 12, grp = head >> 2, dsh = 2 * grp, d = 1 << dsh;
            int sbase, T, c;
            if (chunk < 32) { sbase = 0; T = T_PROMPT; c = chunk; } else if (chunk < 64) { sbase = T_PROMPT; T = T_PROMPT; c = chunk - 32; }
            else if (chunk < 128) { sbase = 2 * T_PROMPT; T = T_SAMPLE; c = chunk - 64; } else { sbase = 2 * T_PROMPT + T_SAMPLE; T = T_SAMPLE; c = chunk - 128; }
            const int r = c & (d - 1), b = c >> dsh, nblk = (T >> dsh) / 256;
            const int jlo_u = (b == 0) ? 1 : 0, jhi_u = (b == nblk - 1) ? 4 : 5;
            const long rstride = (long)d * NQKV;
            const bf16_t* base = QKV + (long)(sbase + r) * NQKV + head * 64;
            const bf16_t* Kg = base + 768 + (long)(256 * b - 64) * rstride; const bf16_t* Vg = base + 1536 + (long)(256 * b - 64) * rstride;
            att::stage_kv<6>(lds, Kg, Vg, rstride, 64 * jlo_u, 64 * jhi_u + 64, tid);
            __syncthreads();
            {
                const int w = wave; const int jlo = (w >> 1) > jlo_u ? (w >> 1) : jlo_u; const int jhi = ((w >> 1) + 2) < jhi_u ? ((w >> 1) + 2) : jhi_u;
                const float slope = fast_exp2(-8.0f * (float)(head + 1) / 12.0f);
                bf16_t* Qg = QKV + (long)(sbase + r) * NQKV + head * 64 + (long)(256 * b + 32 * w) * rstride;
                f32x16 o0, o1; float l;
                att::attn_task<64>(lds, Qg, rstride, jlo, jhi, 64 + 32 * w, -slope * LOG2E * (float)d, -shiftA, o0, o1, l);
                if (lane < 32) ltab[(size_t)(sbase + r + (long)(256 * b + 32 * w + lane) * d) * 12 + head] = l;
                att::attn_store(lds, o0, o1, l, 0.f, Qg, rstride, w);
            }
            __syncthreads();
        }
        for (int ub = bx; ub < (NTOK / 64) * 2; ub += G) {
            const int kvh = ub & 1, t0 = (ub >> 1) * 64;
            int sbase, T;
            if (t0 < T_PROMPT) { sbase = 0; T = T_PROMPT; } else if (t0 < 2 * T_PROMPT) { sbase = T_PROMPT; T = T_PROMPT; }
            else if (t0 < 2 * T_PROMPT + T_SAMPLE) { sbase = 2 * T_PROMPT; T = T_SAMPLE; } else { sbase = 2 * T_PROMPT + T_SAMPLE; T = T_SAMPLE; }
            const int b = (t0 - sbase) / 64, nb = T / 64;
            const int jlo_u = (2 - b) > 0 ? (2 - b) : 0, jhi_u = (nb + 1 - b) < 4 ? (nb + 1 - b) : 4;
            const bf16_t* Kg = QKV + (long)(sbase + 64 * (b - 2)) * NQKV + 2816 + kvh * 64; const bf16_t* Vg = Kg + 128;
            att::stage_kv<5>(lds, Kg, Vg, (long)NQKV, 64 * jlo_u, 64 * jhi_u + 64, tid);
            __syncthreads();
            {
                const int w = wave, h = kvh * 4 + (w >> 1), half = w & 1;
                const float slope = fast_exp2(-(float)(h + 1));
                const bf16_t* Qg = QKV + (long)(sbase + 64 * b + 32 * half) * NQKV + 2304 + h * 64;
                f32x16 o0, o1; float l;
                att::attn_task<128>(lds, Qg, (long)NQKV, jlo_u, jhi_u, 128 + 32 * half, -slope * LOG2E, -shiftB, o0, o1, l);
                const float extra = fast_exp2(b_sink[h] * LOG2E - shiftB);
                att::attn_store(lds, o0, o1, l, extra, Y + (long)(sbase + 64 * b + 32 * half) * NY + 256 + h * 64, (long)NY, w);
            }
            __syncthreads();
        }
        if (BOTH(4)) GRID_BAR();
    }
    if (IN(5)) {
        const int gt = vcu * (NWAVES * 64) + tid, NT = G * NWAVES * 64;
        for (int idx = gt; idx < NTOK * 32; idx += NT) {
            const int tok = idx >> 5, part = idx & 31, sl = part >> 3, dch = part & 7;
            const float l0 = ltab[(size_t)tok * 12 + sl], l1 = ltab[(size_t)tok * 12 + 4 + sl], l2 = ltab[(size_t)tok * 12 + 8 + sl];
            const float inv = fast_rcp(l0 + l1 + l2); const float a0 = l0 * inv, a1 = l1 * inv, a2 = l2 * inv;
            const bf16_t* p = QKV + (size_t)tok * NQKV + sl * 64 + dch * 8;
            const u32x4 x0 = *(const u32x4*)p, x1 = *(const u32x4*)(p + 256), x2 = *(const u32x4*)(p + 512);
            u32x4 o;
#pragma unroll
            for (int i = 0; i < 4; ++i) o[i] = cvtpk(a0 * bf_lo(x0[i]) + a1 * bf_lo(x1[i]) + a2 * bf_lo(x2[i]), a0 * bf_hi(x0[i]) + a1 * bf_hi(x1[i]) + a2 * bf_hi(x2[i]));
            *(u32x4*)(Y + (size_t)tok * NY + sl * 64 + dch * 8) = o;
        }
        if (BOTH(5)) GRID_BAR();
    }
    if (IN(6)) {
        { pg8::Gemm g{Y, Wpa_t, NTOK, DM, 256, NY}; pg8::StaticOrder S; S.init(NTOK, DM, G, bx); pg8::EpiPlain E{PA, DM}; pg8::gemm_phase(lds, g, S, E); }
        { pg8::Gemm g{Y + 256, Wpb_t, NTOK, DM, 512, NY}; pg8::StaticOrder S; S.init(NTOK, DM, G, bx); pg8::EpiPlain E{PB, DM}; pg8::gemm_phase(lds, g, S, E); }
        if (BOTH(6)) GRID_BAR();
    }
    if (IN(7)) {
        pg8::Gemm g{HB, Wgate_t, NTOK, 2 * DM, DM, DM}; pg8::StaticOrder S; S.init(NTOK, 2 * DM, G, bx);
        pg8::EpiGate E{MB, ssq1, b_gate, PA, PB};
        pg8::gemm_phase(lds, g, S, E);
        if (BOTH(7)) GRID_BAR();
    }
    if (IN(8)) {
        pg8::Gemm g{MB, Wout_t, NTOK, DM, DM, DM}; pg8::StaticOrder S; S.init(NTOK, DM, G, bx);
        pg8::EpiRes<true> E{out, out, out, HB, ssq2, 1.0f};
        pg8::gemm_phase(lds, g, S, E);
        if (BOTH(8)) GRID_BAR();
    }
    if (IN(9)) {
        pg8::Gemm g{HB, W2gu_t, NTOK, 2 * DFF, DM, DM}; pg8::StaticOrder S; S.init(NTOK, 2 * DFF, G, bx);
        pg8::EpiSwiGLU E{ACT, ssq2};
        pg8::gemm_phase(lds, g, S, E);
        if (BOTH(9)) GRID_BAR();
    }
    if (IN(10)) {
        pg8::Gemm g{ACT, W2d_t, NTOK, DM, DFF, DFF}; pg8::StaticOrder S; S.init(NTOK, DM, G, bx);
        pg8::EpiRes<false> E{out, out, out, nullptr, ssq3, 0.5f};
        pg8::gemm_phase(lds, g, S, E);
        if (BOTH(10)) GRID_BAR();
    }
    if (IN(11)) {
        f32x4 gfin[4];
#pragma unroll
        for (int j = 0; j < 4; ++j) gfin[j] = ((const f32x4*)final_norm)[lane + 64 * j];
        for (int m = gw; m < NTOK; m += NGW) {
            float s = (lane < 16) ? ssq3[(size_t)m * 16 + lane] : 0.f;
            s = wave_sum(s);
            const float rr = fast_rsq(s * (1.0f / DM) + NORM_EPS);
            f32x4* xr = (f32x4*)(out + (size_t)m * DM) + lane;
#pragma unroll
            for (int j = 0; j < 4; ++j) { const f32x4 v = xr[64 * j]; xr[64 * j] = v * rr * gfin[j]; }
        }
    }
#undef IN
#undef BOTH
}

extern "C" void kernel_launch(void* const* d_in, const int* in_sizes, int n_in, void* d_out, int out_size, void* d_ws, size_t ws_size, hipStream_t stream) {
    static int grid = 0;
    if (grid == 0) {
        if (n_in != 23 || out_size != NTOK * DM || ws_size < WS_END) { fprintf(stderr, "kernel_launch: unexpected problem (n_in %d, out %d, ws %zu); nothing launched\n", n_in, out_size, ws_size); grid = -1; return; }
        int dev = 0, cus = 0, per_cu = 0;
        if (hipGetDevice(&dev) != hipSuccess || hipDeviceGetAttribute(&cus, hipDeviceAttributeMultiprocessorCount, dev) != hipSuccess) { fprintf(stderr, "kernel_launch: device query failed\n"); grid = -1; return; }
        if (hipFuncSetAttribute((const void*)enc_fwd, hipFuncAttributeMaxDynamicSharedMemorySize, LDS_BYTES) != hipSuccess) { fprintf(stderr, "kernel_launch: hipFuncSetAttribute failed\n"); grid = -1; return; }
        if (hipOccupancyMaxActiveBlocksPerMultiprocessor(&per_cu, (const void*)enc_fwd, NWAVES * 64, LDS_BYTES) != hipSuccess || per_cu < 1)
            fprintf(stderr, "kernel_launch: note: occupancy query reports %d workgroups per CU\n", per_cu);
        (void)hipGetLastError();
        grid = cus;
    }
    if (grid < 0) return;
    if (hipMemsetAsync((char*)d_ws + WS_CTL, 0, CTL_ZERO_BYTES, stream) != hipSuccess) { fprintf(stderr, "kernel_launch: memset failed\n"); return; }
    Args a{};
    for (int i = 0; i < 23; ++i) a.in[i] = (const float*)d_in[i];
    a.out = (float*)d_out; a.ws = (unsigned char*)d_ws;
#if MK_ONE_LAUNCH
    a.ph_lo = 0; a.ph_hi = NPHASE;
    hipLaunchKernelGGL(enc_fwd, dim3(grid), dim3(NWAVES * 64), LDS_BYTES, stream, a);
#else
    for (int p = 0; p < NPHASE; ++p) { a.ph_lo = p; a.ph_hi = p + 1; hipLaunchKernelGGL(enc_fwd, dim3(grid), dim3(NWAVES * 64), LDS_BYTES, stream, a); }
#endif
    const hipError_t le = hipPeekAtLastError();
    if (le != hipSuccess) fprintf(stderr, "kernel_launch: launch failed: %s\n", hipGetErrorName(le));
}
```

```cpp
#include <hip/hip_runtime.h>
#include <cstdio>
#include <cstdint>

#ifndef MK_ONE_LAUNCH
#define MK_ONE_LAUNCH 1
#endif
#define PROBE_A -1
#define PROBE_B -1
#define PROBE_ON (PROBE_A >= 0 || PROBE_B >= 0)

#define GAS __attribute__((address_space(1)))
#define LAS __attribute__((address_space(3)))
typedef unsigned short bf16_t;
typedef short bf16x8 __attribute__((ext_vector_type(8)));
typedef short s16x4 __attribute__((ext_vector_type(4)));
typedef float f32x4 __attribute__((ext_vector_type(4)));
typedef float f32x16 __attribute__((ext_vector_type(16)));
typedef unsigned u32x4 __attribute__((ext_vector_type(4)));
typedef unsigned u32x2 __attribute__((ext_vector_type(2)));
typedef float f32x2_t __attribute__((ext_vector_type(2)));
typedef __bf16 bf16x2_t __attribute__((ext_vector_type(2)));

constexpr int DM = 1024, DFF = 2816, NTOK = 49152, NQKV = 3072, NY = 768;
constexpr int T_PROMPT = 8192, T_SAMPLE = 16384, NTOK_PROMPT = 16384;
constexpr float NORM_EPS = 1e-6f;
constexpr float LOG2E = 1.4426950408889634f;
constexpr float QSCALE = 0.125f * LOG2E;

__device__ __forceinline__ unsigned cvtpk(float lo, float hi) { f32x2_t v = {lo, hi}; bf16x2_t b = __builtin_convertvector(v, bf16x2_t); return __builtin_bit_cast(unsigned, b); }
__device__ __forceinline__ float bf_lo(unsigned u) { return __builtin_bit_cast(float, u << 16); }
__device__ __forceinline__ float bf_hi(unsigned u) { return __builtin_bit_cast(float, u & 0xffff0000u); }
__device__ __forceinline__ float fast_exp2(float x) { return __builtin_amdgcn_exp2f(x); }
__device__ __forceinline__ float fast_rcp(float x) { return __builtin_amdgcn_rcpf(x); }
__device__ __forceinline__ float fast_rsq(float x) { return __builtin_amdgcn_rsqf(x); }
__device__ __forceinline__ float sigmoidf_(float a) { return fast_rcp(1.0f + fast_exp2(-LOG2E * a)); }

namespace pg8 {
constexpr int BM = 256, BK = 64, HALF = 128, HTB = HALF * BK * 2, STAGE_BYTES = 8 * HTB, NXCD = 8, WGM = 8;
__host__ __device__ __forceinline__ int lds_byte(int r, int c) { const int st = (r >> 4) * 2 + (c >> 5), rr = r & 15, cc = c & 31, ob = rr * 64 + cc * 2; return st * 1024 + (ob ^ (((ob >> 9) & 1) << 5)); }
__host__ __device__ __forceinline__ void stage_rc(int b, int& R, int& C) { const int st = b / 1024, sb = b % 1024, swz = sb ^ (((sb >> 9) & 1) << 5); R = (st >> 1) * 16 + swz / 64; C = (st & 1) * 32 + (swz % 64) / 2; }

struct Unit { int pm, pn; };
struct Gemm { const bf16_t* A; const bf16_t* Bt; int M, N, K, lda; };

struct StaticOrder {
    int nM, nN, nwg, G, c;
    __device__ void init(int M, int N, int G_, int c_) { nM = M / BM; nN = N / BM; nwg = nM * nN; G = G_; c = c_; }
    __device__ bool next(int i, Unit& u) const {
        const long L = (long)i * G + c; if (L >= nwg) return false;
        int wgid = (int)L; { const int q = nwg / NXCD, r = nwg % NXCD, xcd = wgid % NXCD, off = wgid / NXCD; wgid = (xcd < r ? xcd * (q + 1) : r * (q + 1) + (xcd - r) * q) + off; }
        const int nig = WGM * nN, gid = wgid / nig, fm = gid * WGM, gsz = (nM - fm) < WGM ? (nM - fm) : WGM;
        u.pm = fm + ((wgid % nig) % gsz); u.pn = (wgid % nig) / gsz; return true;
    }
};

template <class Epi>
__device__ __forceinline__ void gemm_phase(LAS unsigned char* lds, const Gemm g, const StaticOrder& S, const Epi& E) {
    const int tid = threadIdx.x, wid = __builtin_amdgcn_readfirstlane(tid >> 6), lane = tid & 63, wr = wid >> 2, wc = wid & 3, fr = lane & 15, fq = lane >> 4;
    const int K = g.K, nt = K / BK, lda = g.lda;
    unsigned voffA[2], voffB[2];
#pragma unroll
    for (int i = 0; i < 2; ++i) { int R, C; stage_rc(tid * 16 + i * 8192, R, C); voffA[i] = (unsigned)(R * lda + C) * 2u; voffB[i] = (unsigned)(R * K + C) * 2u; }
    const size_t kstep = (size_t)(BK * 2);
    const size_t hstepA = (size_t)HALF * lda * 2, hstepB = (size_t)HALF * K * 2;
    const size_t tstepA = 2 * hstepA, tstepB = 2 * hstepB;
    const unsigned ldsw = (unsigned)wid * 1024u;
    const int aoff = lds_byte(wr * 64 + fr, fq * 8), boff = lds_byte(wc * 32 + fr, fq * 8);
#define PG8_SA(b, h) (((b) * 2 + (h)) * HTB)
#define PG8_SB(b, h) ((4 + (b) * 2 + (h)) * HTB)
#define PG8_STAGE(bufoff, gbase, voff) do { _Pragma("unroll") for (int _i = 0; _i < 2; ++_i) \
        __builtin_amdgcn_global_load_lds((const unsigned*)((const char*)(gbase) + (voff)[_i]), (LAS unsigned*)(lds + (bufoff) + ldsw + _i * 8192), 16, 0, 0); } while (0)
#define PG8_LDA(dst, b, h) do { _Pragma("unroll") for (int m = 0; m < 4; ++m) _Pragma("unroll") for (int k = 0; k < 2; ++k) dst[m][k] = *(const LAS bf16x8*)(lds + PG8_SA(b, h) + aoff + m * 2048 + k * 1024); } while (0)
#define PG8_LDB(dst, b, h) do { _Pragma("unroll") for (int n = 0; n < 2; ++n) _Pragma("unroll") for (int k = 0; k < 2; ++k) dst[n][k] = *(const LAS bf16x8*)(lds + PG8_SB(b, h) + boff + n * 2048 + k * 1024); } while (0)
#define PG8_MMA(ai, bj, At, Bt) do { __builtin_amdgcn_s_setprio(1); _Pragma("unroll") for (int m = 0; m < 4; ++m) _Pragma("unroll") for (int n = 0; n < 2; ++n) _Pragma("unroll") for (int k = 0; k < 2; ++k) \
        acc[ai][bj][m][n] = __builtin_amdgcn_mfma_f32_16x16x32_bf16(Bt[n][k], At[m][k], acc[ai][bj][m][n], 0, 0, 0); __builtin_amdgcn_s_setprio(0); } while (0)
#define PG8_WAIT_V(n) asm volatile("s_waitcnt vmcnt(" #n ")" ::: "memory")
#define PG8_WAIT_L(n) asm volatile("s_waitcnt lgkmcnt(" #n ")" ::: "memory")
#define PG8_BAR __builtin_amdgcn_s_barrier()
#define PG8_SCHED __builtin_amdgcn_sched_barrier(0)
    Unit cur, nxt; int ui = 0;
    if (!S.next(0, cur)) return;
    f32x4 acc[2][2][4][2];
#pragma unroll
    for (int a = 0; a < 2; ++a)
#pragma unroll
        for (int b = 0; b < 2; ++b)
#pragma unroll
            for (int m = 0; m < 4; ++m)
#pragma unroll
                for (int n = 0; n < 2; ++n) acc[a][b][m][n] = (f32x4){0.f, 0.f, 0.f, 0.f};
    bf16x8 At[4][2], B0[2][2], B1[2][2];
    const char* cA = (const char*)g.A + (size_t)cur.pm * tstepA; const char* cB = (const char*)g.Bt + (size_t)cur.pn * tstepB;
    PG8_STAGE(PG8_SB(0, 0), cB, voffB); PG8_STAGE(PG8_SB(0, 1), cB + hstepB, voffB); PG8_STAGE(PG8_SA(0, 0), cA, voffA); PG8_STAGE(PG8_SA(0, 1), cA + hstepA, voffA);
    if (wr == 1) PG8_BAR;
    PG8_WAIT_V(2); PG8_BAR;
    PG8_STAGE(PG8_SB(1, 0), cB + kstep, voffB); PG8_STAGE(PG8_SA(1, 0), cA + kstep, voffA); PG8_STAGE(PG8_SB(1, 1), cB + hstepB + kstep, voffB);
    PG8_WAIT_V(6); PG8_BAR;
    for (;;) {
        const bool has_next = S.next(ui + 1, nxt);
        const char* nA = has_next ? (const char*)g.A + (size_t)nxt.pm * tstepA : cA; const char* nB = has_next ? (const char*)g.Bt + (size_t)nxt.pn * tstepB : cB;
        for (int t = 0; t < nt; t += 2) {
            const bool last = (t == nt - 2);
            const char* a1 = cA + (size_t)(t + 1) * kstep;
            const char* a2 = last ? nA : cA + (size_t)(t + 2) * kstep; const char* b2 = last ? nB : cB + (size_t)(t + 2) * kstep;
            const char* a3 = a2 + kstep; const char* b3 = b2 + kstep;
            PG8_LDB(B0, 0, 0); PG8_LDB(B1, 0, 1); PG8_SCHED; PG8_LDA(At, 0, 0); PG8_STAGE(PG8_SA(1, 1), a1 + hstepA, voffA);
            PG8_WAIT_V(8); PG8_WAIT_L(0); PG8_BAR; PG8_MMA(0, 0, At, B0); PG8_MMA(0, 1, At, B1); PG8_BAR; PG8_SCHED;
            PG8_LDA(At, 0, 1); PG8_STAGE(PG8_SB(0, 0), b2, voffB); PG8_STAGE(PG8_SB(0, 1), b2 + hstepB, voffB); PG8_STAGE(PG8_SA(0, 0), a2, voffA);
            PG8_WAIT_V(8); PG8_WAIT_L(0); PG8_BAR; PG8_MMA(1, 0, At, B0); PG8_MMA(1, 1, At, B1); PG8_BAR; PG8_SCHED;
            PG8_LDB(B0, 1, 0); PG8_LDB(B1, 1, 1); PG8_SCHED; PG8_LDA(At, 1, 0); PG8_STAGE(PG8_SA(0, 1), a2 + hstepA, voffA);
            PG8_WAIT_V(8); PG8_WAIT_L(0); PG8_BAR; PG8_MMA(0, 0, At, B0); PG8_MMA(0, 1, At, B1); PG8_BAR; PG8_SCHED;
            PG8_LDA(At, 1, 1); PG8_STAGE(PG8_SB(1, 0), b3, voffB); PG8_STAGE(PG8_SB(1, 1), b3 + hstepB, voffB); PG8_STAGE(PG8_SA(1, 0), a3, voffA);
            PG8_WAIT_V(8); PG8_WAIT_L(0); PG8_BAR; PG8_MMA(1, 0, At, B0); PG8_MMA(1, 1, At, B1); PG8_BAR; PG8_SCHED;
        }
        if (wr == 0) PG8_BAR;
        E(acc, cur, wr, wc, fr, fq, lane);
        if (!has_next) break;
#pragma unroll
        for (int a = 0; a < 2; ++a)
#pragma unroll
            for (int b = 0; b < 2; ++b)
#pragma unroll
                for (int m = 0; m < 4; ++m)
#pragma unroll
                    for (int n = 0; n < 2; ++n) acc[a][b][m][n] = (f32x4){0.f, 0.f, 0.f, 0.f};
        cur = nxt; cA = nA; cB = nB; ++ui;
        if (wr == 1) PG8_BAR;
    }
    PG8_WAIT_V(0);
    PG8_BAR;
#undef PG8_SA
#undef PG8_SB
#undef PG8_STAGE
#undef PG8_LDA
#undef PG8_LDB
#undef PG8_MMA
#undef PG8_WAIT_V
#undef PG8_WAIT_L
#undef PG8_BAR
#undef PG8_SCHED
}

__device__ __forceinline__ void row_rs(const float* ssq, int pm, int wr, int lane, float& r0, float& r1) {
    const f32x4* p0 = (const f32x4*)(ssq + (size_t)(pm * BM + wr * 64 + lane) * 16); const f32x4* p1 = p0 + HALF * 4;
    const f32x4 a0 = p0[0], a1 = p0[1], a2 = p0[2], a3 = p0[3], b0 = p1[0], b1 = p1[1], b2 = p1[2], b3 = p1[3];
    const f32x4 sa = (a0 + a1) + (a2 + a3), sb = (b0 + b1) + (b2 + b3);
    r0 = fast_rsq(((sa[0] + sa[1]) + (sa[2] + sa[3])) * (1.0f / DM) + NORM_EPS);
    r1 = fast_rsq(((sb[0] + sb[1]) + (sb[2] + sb[3])) * (1.0f / DM) + NORM_EPS);
}

struct EpiSwiGLU {
    bf16_t* O; const float* ssq;
    __device__ __forceinline__ void operator()(const f32x4 (&acc)[2][2][4][2], const Unit& u, int wr, int wc, int fr, int fq, int lane) const {
        float r0, r1; row_rs(ssq, u.pm, wr, lane, r0, r1);
        const int col0 = u.pn * 128 + wc * 32 + fq * 8;
#pragma unroll
        for (int ai = 0; ai < 2; ++ai)
#pragma unroll
            for (int m = 0; m < 4; ++m) {
                const float rr = __shfl(ai ? r1 : r0, 16 * m + fr);
                const size_t row = (size_t)(u.pm * BM + ai * HALF + wr * 64 + m * 16 + fr);
                float o[8];
#pragma unroll
                for (int bj = 0; bj < 2; ++bj)
#pragma unroll
                    for (int e = 0; e < 4; ++e) { const float gt = acc[ai][bj][m][0][e] * rr, up = acc[ai][bj][m][1][e] * rr;
                        o[bj * 4 + e] = gt * up * fast_rcp(1.0f + fast_exp2(-LOG2E * gt)); }
                u32x4 w; w.x = cvtpk(o[0], o[1]); w.y = cvtpk(o[2], o[3]); w.z = cvtpk(o[4], o[5]); w.w = cvtpk(o[6], o[7]);
                *(u32x4*)(O + row * DFF + col0) = w;
            }
    }
};

template <bool F32OUT> struct EpiRes {
    bf16_t* hb; float* out; float* ssq; float scale;
    __device__ __forceinline__ void operator()(const f32x4 (&acc)[2][2][4][2], const Unit& u, int wr, int wc, int fr, int fq, int lane) const {
        const int col0 = u.pn * BM + wc * 32 + 8 * fq;
        const size_t rowb = (size_t)(u.pm * BM + wr * 64 + fr);
        u32x4 rs[2][4][2];
#pragma unroll
        for (int ai = 0; ai < 2; ++ai)
#pragma unroll
            for (int m = 0; m < 4; ++m)
#pragma unroll
                for (int bj = 0; bj < 2; ++bj) rs[ai][m][bj] = *(const u32x4*)(hb + (rowb + ai * HALF + m * 16) * DM + col0 + bj * HALF);
#pragma unroll
        for (int ai = 0; ai < 2; ++ai)
#pragma unroll
            for (int m = 0; m < 4; ++m) {
                const size_t row = rowb + ai * HALF + m * 16; const size_t off = row * DM + col0;
                float ss = 0.f;
#pragma unroll
                for (int bj = 0; bj < 2; ++bj) { const u32x4 r = rs[ai][m][bj]; const f32x4 a0 = acc[ai][bj][m][0] * scale, a1 = acc[ai][bj][m][1] * scale;
                    f32x4 v0, v1; v0[0] = bf_lo(r[0]) + a0[0]; v0[1] = bf_hi(r[0]) + a0[1]; v0[2] = bf_lo(r[1]) + a0[2]; v0[3] = bf_hi(r[1]) + a0[3];
                    v1[0] = bf_lo(r[2]) + a1[0]; v1[1] = bf_hi(r[2]) + a1[1]; v1[2] = bf_lo(r[3]) + a1[2]; v1[3] = bf_hi(r[3]) + a1[3];
                    ss += ((v0[0] * v0[0] + v0[1] * v0[1]) + (v0[2] * v0[2] + v0[3] * v0[3])) + ((v1[0] * v1[0] + v1[1] * v1[1]) + (v1[2] * v1[2] + v1[3] * v1[3]));
                    if (F32OUT) { *(f32x4*)(out + off + bj * HALF) = v0; *(f32x4*)(out + off + bj * HALF + 4) = v1; }
                    else { u32x4 w; w.x = cvtpk(v0[0], v0[1]); w.y = cvtpk(v0[2], v0[3]); w.z = cvtpk(v1[0], v1[1]); w.w = cvtpk(v1[2], v1[3]); *(u32x4*)(hb + off + bj * HALF) = w; } }
                ss += __shfl_xor(ss, 16); ss += __shfl_xor(ss, 32);
                if (fq == 0) ssq[row * 16 + u.pn * 4 + wc] = ss;
            }
    }
};

struct EpiQKV {
    bf16_t* O; const float* ssq; const float *gaq, *gak, *gbq, *gbk;
    __device__ __forceinline__ void operator()(const f32x4 (&acc)[2][2][4][2], const Unit& u, int wr, int wc, int fr, int fq, int lane) const {
        float r0, r1; row_rs(ssq, u.pm, wr, lane, r0, r1);
        const float* gp = nullptr; float qs = 1.0f;
        if (u.pn < 3) { gp = gaq; qs = QSCALE; } else if (u.pn < 6) { gp = gak; } else if (u.pn < 9) { gp = nullptr; } else if (u.pn < 11) { gp = gbq; qs = QSCALE; } else if (wc < 2) { gp = gbk; }
        float gn[16];
#pragma unroll
        for (int i = 0; i < 16; ++i) gn[i] = 1.0f;
        if (gp) {
#pragma unroll
            for (int i = 0; i < 4; ++i) { const f32x4 t = *(const f32x4*)(gp + 16 * fq + 4 * i); gn[4 * i] = t[0] * qs; gn[4 * i + 1] = t[1] * qs; gn[4 * i + 2] = t[2] * qs; gn[4 * i + 3] = t[3] * qs; }
        }
        const int col0 = u.pn * BM + wc * 64 + fq * 16;
#pragma unroll
        for (int ai = 0; ai < 2; ++ai)
#pragma unroll
            for (int m = 0; m < 4; ++m) {
                const float rr = __shfl(ai ? r1 : r0, 16 * m + fr);
                const size_t row = (size_t)(u.pm * BM + ai * HALF + wr * 64 + m * 16 + fr);
                float v[16]; float ss = 0.f;
#pragma unroll
                for (int bj = 0; bj < 2; ++bj)
#pragma unroll
                    for (int n = 0; n < 2; ++n)
#pragma unroll
                        for (int e = 0; e < 4; ++e) { const float x = acc[ai][bj][m][n][e] * rr; v[bj * 8 + n * 4 + e] = x; ss += x * x; }
                ss += __shfl_xor(ss, 16); ss += __shfl_xor(ss, 32);
                const float hr = gp ? fast_rsq(ss * (1.0f / 64.0f) + NORM_EPS) : 1.0f;
#pragma unroll
                for (int i = 0; i < 16; ++i) v[i] = v[i] * hr * gn[i];
                u32x4 w0, w1; w0.x = cvtpk(v[0], v[1]); w0.y = cvtpk(v[2], v[3]); w0.z = cvtpk(v[4], v[5]); w0.w = cvtpk(v[6], v[7]);
                w1.x = cvtpk(v[8], v[9]); w1.y = cvtpk(v[10], v[11]); w1.z = cvtpk(v[12], v[13]); w1.w = cvtpk(v[14], v[15]);
                bf16_t* p = O + row * NQKV + col0; *(u32x4*)p = w0; *(u32x4*)(p + 8) = w1;
            }
    }
};

struct EpiPlain {
    bf16_t* O; int ldc;
    __device__ __forceinline__ void operator()(const f32x4 (&acc)[2][2][4][2], const Unit& u, int wr, int wc, int fr, int fq, int lane) const {
        const int col0 = u.pn * BM + wc * 32 + fq * 8;
#pragma unroll
        for (int ai = 0; ai < 2; ++ai)
#pragma unroll
            for (int m = 0; m < 4; ++m) {
                const size_t row = (size_t)(u.pm * BM + ai * HALF + wr * 64 + m * 16 + fr);
#pragma unroll
                for (int bj = 0; bj < 2; ++bj) { const f32x4 v0 = acc[ai][bj][m][0], v1 = acc[ai][bj][m][1];
                    u32x4 w; w.x = cvtpk(v0[0], v0[1]); w.y = cvtpk(v0[2], v0[3]); w.z = cvtpk(v1[0], v1[1]); w.w = cvtpk(v1[2], v1[3]);
                    *(u32x4*)(O + row * ldc + col0 + bj * HALF) = w; }
            }
    }
};

struct EpiGate {
    bf16_t* O; const float* ssq; const float* bgate; const bf16_t* PA; const bf16_t* PB;
    __device__ __forceinline__ void operator()(const f32x4 (&acc)[2][2][4][2], const Unit& u, int wr, int wc, int fr, int fq, int lane) const {
        float r0, r1; row_rs(ssq, u.pm, wr, lane, r0, r1);
        const int col0 = u.pn * 128 + wc * 32 + fq * 8;
        float ba[8], bb[8];
        { const f32x4 t0 = *(const f32x4*)(bgate + col0), t1 = *(const f32x4*)(bgate + col0 + 4), t2 = *(const f32x4*)(bgate + DM + col0), t3 = *(const f32x4*)(bgate + DM + col0 + 4);
#pragma unroll
          for (int e = 0; e < 4; ++e) { ba[e] = t0[e]; ba[4 + e] = t1[e]; bb[e] = t2[e]; bb[4 + e] = t3[e]; } }
        u32x4 pas[2][4], pbs[2][4];
#pragma unroll
        for (int ai = 0; ai < 2; ++ai)
#pragma unroll
            for (int m = 0; m < 4; ++m) { const size_t row = (size_t)(u.pm * BM + ai * HALF + wr * 64 + m * 16 + fr);
                pas[ai][m] = *(const u32x4*)(PA + row * DM + col0); pbs[ai][m] = *(const u32x4*)(PB + row * DM + col0); }
#pragma unroll
        for (int ai = 0; ai < 2; ++ai)
#pragma unroll
            for (int m = 0; m < 4; ++m) {
                const float rr = __shfl(ai ? r1 : r0, 16 * m + fr);
                const size_t row = (size_t)(u.pm * BM + ai * HALF + wr * 64 + m * 16 + fr);
                const u32x4 pa = pas[ai][m], pb = pbs[ai][m];
                float o[8];
#pragma unroll
                for (int bj = 0; bj < 2; ++bj)
#pragma unroll
                    for (int e = 0; e < 4; ++e) { const int i = bj * 4 + e;
                        const float ga = sigmoidf_(acc[ai][bj][m][0][e] * rr + ba[i]), gb = sigmoidf_(acc[ai][bj][m][1][e] * rr + bb[i]);
                        const unsigned wa = pa[i >> 1], wb = pb[i >> 1];
                        const float xa = (i & 1) ? bf_hi(wa) : bf_lo(wa), xb = (i & 1) ? bf_hi(wb) : bf_lo(wb);
                        o[i] = ga * xa + gb * xb; }
                u32x4 w; w.x = cvtpk(o[0], o[1]); w.y = cvtpk(o[2], o[3]); w.z = cvtpk(o[4], o[5]); w.w = cvtpk(o[6], o[7]);
                *(u32x4*)(O + row * DM + col0) = w;
            }
    }
};
}

namespace att {
constexpr int KPL = 6144 + 16, VPL = 24576 + 64;
constexpr int OFF_K = 0, OFF_V = 8 * KPL, OFF_WS = OFF_V + 2 * VPL, OFF_OST = OFF_WS + 8 * 256, LDS_BYTES = OFF_OST + 8 * 4096;
__device__ __forceinline__ int crow(int r, int hi) { return (r & 3) + 8 * (r >> 2) + 4 * hi; }
__device__ __forceinline__ s16x4 vtr(const LAS unsigned char* p) { return __builtin_bit_cast(s16x4, __builtin_amdgcn_ds_read_tr16_b64_v4i16((LAS s16x4*)p)); }

template <int NIT>
__device__ __forceinline__ void stage_kv(LAS unsigned char* lds, const bf16_t* Kg, const bf16_t* Vg, long rstride, int row_lo, int row_hi, int tid) {
    u32x4 kv[NIT], vv[NIT];
#pragma unroll
    for (int it = 0; it < NIT; ++it) { const int q = tid + it * 512, row = q >> 3, c = q & 7;
        if (row >= row_lo && row < row_hi) { kv[it] = *(const u32x4*)(Kg + (long)row * rstride + c * 8); vv[it] = *(const u32x4*)(Vg + (long)row * rstride + c * 8); } }
#pragma unroll
    for (int it = 0; it < NIT; ++it) { const int q = tid + it * 512, row = q >> 3, c = q & 7;
        if (row >= row_lo && row < row_hi) { *(LAS u32x4*)(lds + OFF_K + c * KPL + row * 16) = kv[it]; *(LAS u32x4*)(lds + OFF_V + (c >> 2) * VPL + row * 64 + (c & 3) * 16) = vv[it]; } }
}

template <int HW>
__device__ __forceinline__ void attn_task(LAS unsigned char* lds, const bf16_t* Qg, long qstride, int jlo, int jhi, int qoff, float nslope2, float nshift, f32x16& o0, f32x16& o1, float& lsum) {
    const int lane = threadIdx.x & 63, r32 = lane & 31, hi = lane >> 5;
    bf16x8 qr[4];
#pragma unroll
    for (int d0 = 0; d0 < 4; ++d0) qr[d0] = *(const bf16x8*)(Qg + (long)r32 * qstride + d0 * 16 + hi * 8);
    const LAS unsigned char* kp = lds + OFF_K + hi * KPL + r32 * 16;
    const LAS unsigned char* vp = lds + OFF_V + ((lane >> 4) & 1) * 32 + (lane & 3) * 8 + (4 * hi + ((lane & 15) >> 2)) * 64;
    f32x16 negs;
#pragma unroll
    for (int r = 0; r < 16; ++r) negs[r] = nshift;
    f32x16 oa = {}, ob = {}; float l = 0.f;
    for (int j = jlo; j <= jhi; ++j) {
        const LAS unsigned char* kt = kp + j * 1024;
        f32x16 p0 = negs, p1 = negs;
#pragma unroll
        for (int d0 = 0; d0 < 4; ++d0) { const bf16x8 b0 = *(const LAS bf16x8*)(kt + 2 * d0 * KPL), b1 = *(const LAS bf16x8*)(kt + 2 * d0 * KPL + 512);
            p0 = __builtin_amdgcn_mfma_f32_32x32x16_bf16(b0, qr[d0], p0, 0, 0, 0); p1 = __builtin_amdgcn_mfma_f32_32x32x16_bf16(b1, qr[d0], p1, 0, 0, 0); }
        const float basef = (float)(qoff + r32 - 64 * j - 4 * hi);
        float s = 0.f;
#pragma unroll
        for (int r = 0; r < 16; ++r) { const float cc = (float)((r & 3) + 8 * (r >> 2));
            const float a0 = __builtin_fabsf(basef - cc), a1 = __builtin_fabsf(basef - cc - 32.0f);
            float v0 = __builtin_fmaf(a0, nslope2, p0[r]), v1 = __builtin_fmaf(a1, nslope2, p1[r]);
            v0 = (a0 <= (float)HW) ? v0 : -INFINITY; v1 = (a1 <= (float)HW) ? v1 : -INFINITY;
            p0[r] = fast_exp2(v0); p1[r] = fast_exp2(v1); s += p0[r] + p1[r]; }
        l += s;
        u32x4 pw[4];
#pragma unroll
        for (int i = 0; i < 4; ++i) { pw[0][i] = cvtpk(p0[2 * i], p0[2 * i + 1]); pw[1][i] = cvtpk(p0[8 + 2 * i], p0[9 + 2 * i]); pw[2][i] = cvtpk(p1[2 * i], p1[2 * i + 1]); pw[3][i] = cvtpk(p1[8 + 2 * i], p1[9 + 2 * i]); }
        const LAS unsigned char* vt = vp + j * 4096;
#pragma unroll
        for (int ks = 0; ks < 4; ++ks) {
            const s16x4 lo0 = vtr(vt + ks * 1024), hi0 = vtr(vt + ks * 1024 + 512), lo1 = vtr(vt + VPL + ks * 1024), hi1 = vtr(vt + VPL + ks * 1024 + 512);
            const bf16x8 pa = __builtin_bit_cast(bf16x8, pw[ks]);
            const bf16x8 v0 = (bf16x8){lo0[0], lo0[1], lo0[2], lo0[3], hi0[0], hi0[1], hi0[2], hi0[3]}, v1 = (bf16x8){lo1[0], lo1[1], lo1[2], lo1[3], hi1[0], hi1[1], hi1[2], hi1[3]};
            oa = __builtin_amdgcn_mfma_f32_32x32x16_bf16(pa, v0, oa, 0, 0, 0); ob = __builtin_amdgcn_mfma_f32_32x32x16_bf16(pa, v1, ob, 0, 0, 0);
        }
    }
    l += __shfl_xor(l, 32);
    o0 = oa; o1 = ob; lsum = l;
}

__device__ __forceinline__ void attn_store(LAS unsigned char* lds, const f32x16& o0, const f32x16& o1, float l, float extra, bf16_t* Og, long ostride, int wid) {
    const int lane = threadIdx.x & 63, r32 = lane & 31, hi = lane >> 5;
    LAS float* wsf = (LAS float*)(lds + OFF_WS + wid * 256);
    if (hi == 0) wsf[r32] = fast_rcp(l + extra);
    LAS bf16_t* stg = (LAS bf16_t*)(lds + OFF_OST + wid * 4096);
#pragma unroll
    for (int r = 0; r < 16; ++r) { const int orow = crow(r, hi); const float rl = wsf[orow];
        const unsigned a = cvtpk(o0[r] * rl, 0.f), b = cvtpk(o1[r] * rl, 0.f);
        stg[orow * 64 + r32] = (bf16_t)(a & 0xffffu); stg[orow * 64 + 32 + r32] = (bf16_t)(b & 0xffffu); }
#pragma unroll
    for (int i = 0; i < 4; ++i) { const int row = i * 8 + (lane >> 3), ch = lane & 7; const u32x4 v = *(const LAS u32x4*)(stg + row * 64 + ch * 8); *(u32x4*)(Og + (long)row * ostride + ch * 8) = v; }
}
}

constexpr int NWAVES = 8;
constexpr int NPHASE = 12;
constexpr size_t MiB = 1u << 20;
constexpr size_t WS_CTL = 0, CTL_ZERO_BYTES = 1 * MiB;
constexpr size_t WS_SSQ0 = 1 * MiB, WS_SSQ1 = 4 * MiB, WS_SSQ2 = 7 * MiB, WS_SSQ3 = 10 * MiB;
constexpr size_t WS_LTAB = 13 * MiB;
constexpr size_t WS_WIN = 16 * MiB, WS_WGATE = 22 * MiB, WS_WPA = 26 * MiB, WS_WPB = 27 * MiB, WS_WOUT = 28 * MiB, WS_W2GU = 30 * MiB, WS_W2D = 41 * MiB;
constexpr size_t WS_HB = 47 * MiB;
constexpr size_t WS_W1GU = 143 * MiB, WS_W1D = 154 * MiB;
constexpr size_t WS_Y = 143 * MiB;
constexpr size_t WS_ACT = 160 * MiB;
constexpr size_t WS_QKV = 215 * MiB;
constexpr size_t WS_PA = 215 * MiB, WS_PB = 311 * MiB, WS_M = 407 * MiB;
constexpr size_t WS_END = 503 * MiB;
constexpr int CW_BAR = 4096;

constexpr int RING_BYTES = 134144;
constexpr int LDSCTL_OFF = RING_BYTES, MISC_OFF = LDSCTL_OFF + 320;
constexpr int LDS_BYTES = 147456;
static_assert(att::LDS_BYTES <= RING_BYTES && pg8::STAGE_BYTES <= RING_BYTES && MISC_OFF + 128 <= LDS_BYTES, "LDS map");

typedef GAS unsigned gu32;
#define RLX_AGENT __ATOMIC_RELAXED, __HIP_MEMORY_SCOPE_AGENT
#define LDS_WAIT() asm volatile("s_waitcnt lgkmcnt(0)" ::: "memory")

#define XB_TMO      128
#define XB_XCNT(j)  (256  + 64 * (j))
#define XB_XSUB(j)  (1280 + 64 * (j))
#define XB_XGEN(j)  (2304 + 64 * (j))
#define XB_TOP      3328
#define XB_TOPGEN   3392
#define XCD_BAR_WORDS 3456
#define XB_SPIN_CAP (1u << 18)
__device__ __forceinline__ unsigned xb_ld(unsigned* p)              { return __hip_atomic_load(p, __ATOMIC_RELAXED, __HIP_MEMORY_SCOPE_AGENT); }
__device__ __forceinline__ unsigned xb_add(unsigned* p, unsigned v) { return __hip_atomic_fetch_add(p, v, __ATOMIC_RELAXED, __HIP_MEMORY_SCOPE_AGENT); }
__device__ __forceinline__ unsigned xb_xcc_id() { return (unsigned)__builtin_amdgcn_s_getreg((3 << 11) | 20) & 0xFu; }
#define XB_SPIN(cond, bar) do { unsigned _sp = 0; while (cond) { __builtin_amdgcn_s_sleep(1); \
    if ((++_sp & 255u) == 0u) { if (xb_ld(&(bar)[XB_TMO])) break; if (_sp > XB_SPIN_CAP) { atomicAdd(&(bar)[XB_TMO], 1u); break; } } } } while (0)
struct XcdBarrier { unsigned* bar; unsigned x; volatile LAS unsigned* st; };
__device__ __forceinline__ XcdBarrier xcd_barrier_post(unsigned* bar, volatile LAS unsigned* st) {
    XcdBarrier b; b.bar = bar; b.x = xb_xcc_id(); b.st = st;
    if (threadIdx.x == 0) (void)xb_add(&bar[XB_XCNT(b.x)], 1u);
    return b;
}
__device__ __forceinline__ void xcd_barrier_complete(unsigned* bar, unsigned x, unsigned& nloc, unsigned& nx) {
    const unsigned G = gridDim.x * gridDim.y * gridDim.z;
    unsigned sum, cnt, mine, sp = 0u;
    for (;;) {
        sum = 0u; cnt = 0u; mine = 0u;
#pragma unroll
        for (unsigned j = 0; j < 16; ++j) { const unsigned c = xb_ld(&bar[XB_XCNT(j)]); sum += c; cnt += (c > 0u) ? 1u : 0u; mine = (j == x) ? c : mine; }
        if (sum == G) break;
        __builtin_amdgcn_s_sleep(1);
        if ((++sp & 255u) == 0u) { if (xb_ld(&bar[XB_TMO])) break; if (sp > XB_SPIN_CAP) { atomicAdd(&bar[XB_TMO], 1u); break; } }
    }
    nloc = mine > 0u ? mine : 1u; nx = cnt > 0u ? cnt : 1u;
}
__device__ __forceinline__ void xcd_barrier(const XcdBarrier& b) {
    asm volatile("s_waitcnt vmcnt(0)" ::: "memory");
    __syncthreads();
    if (threadIdx.x == 0) {
        unsigned* bar = b.bar;
        __builtin_amdgcn_s_waitcnt(0);
        unsigned nloc = b.st[0], nx = b.st[1];
        if (nloc == 0u) { xcd_barrier_complete(bar, b.x, nloc, nx); b.st[0] = nloc; b.st[1] = nx; }
        const unsigned old = xb_add(&bar[XB_XSUB(b.x)], 1u);
        const unsigned gen = old / nloc;
        if (old + 1u == (gen + 1u) * nloc) {
            __builtin_amdgcn_fence(__ATOMIC_RELEASE, "agent");
            asm volatile("s_waitcnt vmcnt(0)" ::: "memory");
            const unsigned og = xb_add(&bar[XB_TOP], 1u);
            const unsigned tg = og / nx;
            if (og + 1u == (tg + 1u) * nx) xb_add(&bar[XB_TOPGEN], 1u);
            else XB_SPIN(xb_ld(&bar[XB_TOPGEN]) == tg, bar);
            __builtin_amdgcn_fence(__ATOMIC_ACQUIRE, "agent");
            xb_add(&bar[XB_XGEN(b.x)], 1u);
            asm volatile("s_waitcnt vmcnt(0)" ::: "memory");
        } else {
            XB_SPIN(xb_ld(&bar[XB_XGEN(b.x)]) == gen, bar);
            __builtin_amdgcn_fence(__ATOMIC_ACQUIRE, "agent");
            asm volatile("s_waitcnt vmcnt(0)" ::: "memory");
        }
    }
    __syncthreads();
}

__device__ __forceinline__ float wave_sum(float v) {
#pragma unroll
    for (int o = 1; o < 64; o <<= 1) v += __shfl_xor(v, o);
    return v;
}
__device__ __forceinline__ float wave_max(float v) {
#pragma unroll
    for (int o = 1; o < 64; o <<= 1) v = __builtin_fmaxf(v, __shfl_xor(v, o));
    return v;
}

__device__ __forceinline__ int map_gu(int sel, int col) { const int pn = col >> 7, c = col & 127, wc = c >> 5, fq = (c >> 3) & 3, bj = (c >> 2) & 1, e = c & 3; return 256 * pn + 128 * bj + 32 * wc + 16 * sel + 4 * fq + e; }
__device__ __forceinline__ int map_head(int col) { const int pn = col >> 8, c = col & 255, wc = c >> 6, ch = c & 63, fq = ch >> 4, bj = (ch >> 3) & 1, n = (ch >> 2) & 1, e = ch & 3; return 256 * pn + 128 * bj + 32 * wc + 16 * n + 4 * fq + e; }
__device__ __forceinline__ int map_p8(int col) { const int pn = col >> 8, c = col & 255, bj = c >> 7, wc = (c >> 5) & 3, fq = (c >> 3) & 3, n = (c >> 2) & 1, e = c & 3; return 256 * pn + 128 * bj + 32 * wc + 16 * n + 4 * fq + e; }
template <int MAPK>
__device__ __forceinline__ void transpose_item(const float* W, int K, int N, bf16_t* WT, const float* gain, LAS float* scr, int item, int lane) {
    const int nblk = N / 32, kb = item / nblk, nb = item % nblk, k0 = 64 * kb, n0 = 32 * nb;
#pragma unroll 8
    for (int i = 0; i < 32; ++i) { const int kk = 2 * i + (lane >> 5); const float gsc = gain ? gain[k0 + kk] : 1.0f; scr[kk * 33 + (lane & 31)] = W[(size_t)(k0 + kk) * N + n0 + (lane & 31)] * gsc; }
    LDS_WAIT(); asm volatile("" ::: "memory");
    const int c = lane & 7;
#pragma unroll
    for (int j = 0; j < 4; ++j) { const int n = (lane >> 3) + 8 * j; const LAS float* s = scr + (8 * c) * 33 + n;
        u32x4 o; o.x = cvtpk(s[0 * 33], s[1 * 33]); o.y = cvtpk(s[2 * 33], s[3 * 33]); o.z = cvtpk(s[4 * 33], s[5 * 33]); o.w = cvtpk(s[6 * 33], s[7 * 33]);
        const int col = n0 + n;
        const int row = MAPK == 0 ? col : MAPK == 1 ? map_gu(0, col) : MAPK == 2 ? map_gu(1, col) : MAPK == 3 ? map_head(col) : map_p8(col);
        *(u32x4*)(WT + (size_t)row * K + k0 + 8 * c) = o; }
    LDS_WAIT(); asm volatile("" ::: "memory");
}

struct Args { const float* in[23]; float* out; unsigned char* ws; int ph_lo, ph_hi; };

__global__ void __launch_bounds__(NWAVES * 64, 2) enc_fwd(Args args) {
    extern __shared__ __attribute__((aligned(16))) unsigned char lds_raw[];
    LAS unsigned char* lds = (LAS unsigned char*)lds_raw;
    volatile LAS unsigned* MISC = (volatile LAS unsigned*)(lds + MISC_OFF);
    const int tid = threadIdx.x, lane = tid & 63, wave = __builtin_amdgcn_readfirstlane(tid >> 6);
    const int G = gridDim.x, bx = blockIdx.x;
    const int vcu = (G % 8 == 0) ? (bx % 8) * (G / 8) + bx / 8 : bx;
    unsigned char* ws = args.ws;
    gu32* ctl = (gu32*)(ws + WS_CTL);
    const float* x_prompt = args.in[0]; const float* x_sample = args.in[1];
    const float* ffn1_norm = args.in[2]; const float* ffn1_wg = args.in[3]; const float* ffn1_wu = args.in[4]; const float* ffn1_wd = args.in[5];
    const float* mix_norm = args.in[6]; const float* w_in = args.in[7];
    const float* a_q_norm = args.in[8]; const float* a_k_norm = args.in[9]; const float* b_q_norm = args.in[10]; const float* b_k_norm = args.in[11]; const float* b_sink = args.in[12];
    const float* w_proj_a = args.in[13]; const float* w_proj_b = args.in[14]; const float* w_gate = args.in[15]; const float* b_gate = args.in[16]; const float* w_out = args.in[17];
    const float* ffn2_norm = args.in[18]; const float* ffn2_wg = args.in[19]; const float* ffn2_wu = args.in[20]; const float* ffn2_wd = args.in[21]; const float* final_norm = args.in[22];
    float* out = args.out;
    float* ssq0 = (float*)(ws + WS_SSQ0); float* ssq1 = (float*)(ws + WS_SSQ1); float* ssq2 = (float*)(ws + WS_SSQ2); float* ssq3 = (float*)(ws + WS_SSQ3);
    float* ltab = (float*)(ws + WS_LTAB);
    bf16_t* Win_t = (bf16_t*)(ws + WS_WIN); bf16_t* Wgate_t = (bf16_t*)(ws + WS_WGATE); bf16_t* Wpa_t = (bf16_t*)(ws + WS_WPA); bf16_t* Wpb_t = (bf16_t*)(ws + WS_WPB); bf16_t* Wout_t = (bf16_t*)(ws + WS_WOUT);
    bf16_t* W1gu_t = (bf16_t*)(ws + WS_W1GU); bf16_t* W1d_t = (bf16_t*)(ws + WS_W1D); bf16_t* W2gu_t = (bf16_t*)(ws + WS_W2GU); bf16_t* W2d_t = (bf16_t*)(ws + WS_W2D);
    bf16_t* HB = (bf16_t*)(ws + WS_HB); bf16_t* ACT = (bf16_t*)(ws + WS_ACT); bf16_t* QKV = (bf16_t*)(ws + WS_QKV); bf16_t* Y = (bf16_t*)(ws + WS_Y);
    bf16_t* PA = (bf16_t*)(ws + WS_PA); bf16_t* PB = (bf16_t*)(ws + WS_PB); bf16_t* MB = (bf16_t*)(ws + WS_M);

    for (int u = tid; u < (LDS_BYTES - LDSCTL_OFF) / 4; u += NWAVES * 64) ((LAS unsigned*)(lds + LDSCTL_OFF))[u] = 0u;
    __syncthreads();
#if MK_ONE_LAUNCH
    XcdBarrier bar = xcd_barrier_post((unsigned*)(ctl + CW_BAR), MISC + 8);
#define GRID_BAR() xcd_barrier(bar)
#else
#define GRID_BAR() do { } while (0)
#endif
    const int lo = args.ph_lo, hi = args.ph_hi;
#define IN(k) (lo <= (k) && (k) < hi)
#define BOTH(k) (IN(k) && IN((k) + 1))
#if PROBE_ON
#define STAMP(k) do { if (bx == 0 && tid == 0) __hip_atomic_store(ctl + 16 + (k), (unsigned)__builtin_amdgcn_s_memrealtime(), RLX_AGENT); } while (0)
#else
#define STAMP(k) do { } while (0)
#endif
    const int gw = vcu * NWAVES + wave, NGW = G * NWAVES;

    if (IN(0)) {
        STAMP(0);
        LAS float* scr = (LAS float*)(lds + wave * 16384);
        constexpr int I_GU = (DM / 64) * (DFF / 32), I_D = (DFF / 64) * (DM / 32), I_IN = (DM / 64) * (NQKV / 32), I_GT = (DM / 64) * (2 * DM / 32), I_PA = (256 / 64) * (DM / 32), I_PB = (512 / 64) * (DM / 32), I_O = (DM / 64) * (DM / 32);
        constexpr int NITEMS = 4 * I_GU + 2 * I_D + I_IN + I_GT + I_PA + I_PB + I_O;
        for (int it = gw; it < NITEMS; it += NGW) {
            int r = it;
            if (r < I_GU) { transpose_item<1>(ffn1_wg, DM, DFF, W1gu_t, ffn1_norm, scr, r, lane); continue; } r -= I_GU;
            if (r < I_GU) { transpose_item<2>(ffn1_wu, DM, DFF, W1gu_t, ffn1_norm, scr, r, lane); continue; } r -= I_GU;
            if (r < I_D)  { transpose_item<4>(ffn1_wd, DFF, DM, W1d_t, nullptr, scr, r, lane); continue; } r -= I_D;
            if (r < I_IN) { transpose_item<3>(w_in, DM, NQKV, Win_t, mix_norm, scr, r, lane); continue; } r -= I_IN;
            if (r < I_GT) {
                const int nblk = 2 * DM / 32, nb = r % nblk;
                if (nb < DM / 32) transpose_item<1>(w_gate, DM, 2 * DM, Wgate_t, mix_norm, scr, r, lane);
                else {
                    const int kb = r / nblk, k0 = 64 * kb, n0 = 32 * nb;
#pragma unroll 8
                    for (int i = 0; i < 32; ++i) { const int kk = 2 * i + (lane >> 5); scr[kk * 33 + (lane & 31)] = w_gate[(size_t)(k0 + kk) * (2 * DM) + n0 + (lane & 31)] * mix_norm[k0 + kk]; }
                    LDS_WAIT(); asm volatile("" ::: "memory");
                    const int c = lane & 7;
#pragma unroll
                    for (int j = 0; j < 4; ++j) { const int n = (lane >> 3) + 8 * j; const LAS float* s = scr + (8 * c) * 33 + n;
                        u32x4 o; o.x = cvtpk(s[0 * 33], s[1 * 33]); o.y = cvtpk(s[2 * 33], s[3 * 33]); o.z = cvtpk(s[4 * 33], s[5 * 33]); o.w = cvtpk(s[6 * 33], s[7 * 33]);
                        const int row = map_gu(1, n0 + n - DM);
                        *(u32x4*)(Wgate_t + (size_t)row * DM + k0 + 8 * c) = o; }
                    LDS_WAIT(); asm volatile("" ::: "memory");
                }
                continue; } r -= I_GT;
            if (r < I_PA) { transpose_item<4>(w_proj_a, 256, DM, Wpa_t, nullptr, scr, r, lane); continue; } r -= I_PA;
            if (r < I_PB) { transpose_item<4>(w_proj_b, 512, DM, Wpb_t, nullptr, scr, r, lane); continue; } r -= I_PB;
            if (r < I_O)  { transpose_item<4>(w_out, DM, DM, Wout_t, nullptr, scr, r, lane); continue; } r -= I_O;
            if (r < I_GU) { transpose_item<1>(ffn2_wg, DM, DFF, W2gu_t, ffn2_norm, scr, r, lane); continue; } r -= I_GU;
            if (r < I_GU) { transpose_item<2>(ffn2_wu, DM, DFF, W2gu_t, ffn2_norm, scr, r, lane); continue; } r -= I_GU;
            transpose_item<4>(ffn2_wd, DFF, DM, W2d_t, nullptr, scr, r, lane);
        }
        for (int m0 = gw * 4; m0 < NTOK; m0 += NGW * 4) {
            const float* xrow = (m0 < NTOK_PROMPT) ? x_prompt + (size_t)m0 * DM : x_sample + (size_t)(m0 - NTOK_PROMPT) * DM;
            f32x4 v[4][4]; float sq[4];
#pragma unroll
            for (int q = 0; q < 4; ++q)
#pragma unroll
                for (int j = 0; j < 4; ++j) v[q][j] = ((const f32x4*)(xrow + (size_t)q * DM))[lane + 64 * j];
#pragma unroll
            for (int q = 0; q < 4; ++q) { float t = 0.f;
#pragma unroll
                for (int j = 0; j < 4; ++j) t += (v[q][j][0] * v[q][j][0] + v[q][j][1] * v[q][j][1]) + (v[q][j][2] * v[q][j][2] + v[q][j][3] * v[q][j][3]);
                sq[q] = t; }
#pragma unroll
            for (int o = 1; o < 64; o <<= 1) {
#pragma unroll
                for (int q = 0; q < 4; ++q) sq[q] += __shfl_xor(sq[q], o); }
#pragma unroll
            for (int q = 0; q < 4; ++q) { u32x2* o8 = (u32x2*)(HB + (size_t)(m0 + q) * DM) + lane;
#pragma unroll
                for (int j = 0; j < 4; ++j) { u32x2 w; w.x = cvtpk(v[q][j][0], v[q][j][1]); w.y = cvtpk(v[q][j][2], v[q][j][3]); o8[64 * j] = w; } }
            { const int q = lane >> 4, i = lane & 15; const float sv = (q == 0) ? sq[0] : (q == 1) ? sq[1] : (q == 2) ? sq[2] : sq[3]; ssq0[(size_t)(m0 + q) * 16 + i] = (i == 0) ? sv : 0.f; }
        }
        if (BOTH(0)) GRID_BAR();
    }
    if (IN(1)) {
        STAMP(1);
        pg8::Gemm g{HB, W1gu_t, NTOK, 2 * DFF, DM, DM}; pg8::StaticOrder S; S.init(NTOK, 2 * DFF, G, bx);
        pg8::EpiSwiGLU E{ACT, ssq0};
        pg8::gemm_phase(lds, g, S, E);
        if (BOTH(1)) GRID_BAR();
    }
    if (IN(2)) {
        STAMP(2);
        pg8::Gemm g{ACT, W1d_t, NTOK, DM, DFF, DFF}; pg8::StaticOrder S; S.init(NTOK, DM, G, bx);
        pg8::EpiRes<false> E{HB, nullptr, ssq1, 0.5f};
        pg8::gemm_phase(lds, g, S, E);
        if (BOTH(2)) GRID_BAR();
    }
    if (IN(3)) {
        STAMP(3);
        pg8::Gemm g{HB, Win_t, NTOK, NQKV, DM, DM}; pg8::StaticOrder S; S.init(NTOK, NQKV, G, bx);
        pg8::EpiQKV E{QKV, ssq1, a_q_norm, a_k_norm, b_q_norm, b_k_norm};
        pg8::gemm_phase(lds, g, S, E);
        if (BOTH(3)) GRID_BAR();
    }
    if (IN(4)) {
        STAMP(4);
        const float mqa = wave_max(__builtin_fabsf(a_q_norm[lane])), mka = wave_max(__builtin_fabsf(a_k_norm[lane]));
        const float mqb = wave_max(__builtin_fabsf(b_q_norm[lane])), mkb = wave_max(__builtin_fabsf(b_k_norm[lane]));
        const float shiftA = 64.0f * QSCALE * mqa * mka, shiftB = 64.0f * QSCALE * mqb * mkb;
        for (int ua = bx; ua < (NTOK / 256) * 12; ua += G) {
            const int head = ua % 12, chunk = ua / 12, grp = head >> 2, dsh = 2 * grp, d = 1 << dsh;
            int sbase, T, c;
            if (chunk < 32) { sbase = 0; T = T_PROMPT; c = chunk; } else if (chunk < 64) { sbase = T_PROMPT; T = T_PROMPT; c = chunk - 32; }
            else if (chunk < 128) { sbase = 2 * T_PROMPT; T = T_SAMPLE; c = chunk - 64; } else { sbase = 2 * T_PROMPT + T_SAMPLE; T = T_SAMPLE; c = chunk - 128; }
            const int r = c & (d - 1), b = c >> dsh, nblk = (T >> dsh) / 256;
            const int jlo_u = (b == 0) ? 1 : 0, jhi_u = (b == nblk - 1) ? 4 : 5;
            const long rstride = (long)d * NQKV;
            const bf16_t* base = QKV + (long)(sbase + r) * NQKV + head * 64;
            const bf16_t* Kg = base + 768 + (long)(256 * b - 64) * rstride; const bf16_t* Vg = base + 1536 + (long)(256 * b - 64) * rstride;
            att::stage_kv<6>(lds, Kg, Vg, rstride, 64 * jlo_u, 64 * jhi_u + 64, tid);
            __syncthreads();
            {
                const int w = wave; const int jlo = (w >> 1) > jlo_u ? (w >> 1) : jlo_u; const int jhi = ((w >> 1) + 2) < jhi_u ? ((w >> 1) + 2) : jhi_u;
                const float slope = fast_exp2(-8.0f * (float)(head + 1) / 12.0f);
                bf16_t* Qg = QKV + (long)(sbase + r) * NQKV + head * 64 + (long)(256 * b + 32 * w) * rstride;
                f32x16 o0, o1; float l;
                att::attn_task<64>(lds, Qg, rstride, jlo, jhi, 64 + 32 * w, -slope * LOG2E * (float)d, -shiftA, o0, o1, l);
                if (lane < 32) ltab[(size_t)(sbase + r + (long)(256 * b + 32 * w + lane) * d) * 12 + head] = l;
                att::attn_store(lds, o0, o1, l, 0.f, Qg, rstride, w);
            }
            __syncthreads();
        }
        for (int ub = bx; ub < (NTOK / 64) * 2; ub += G) {
            const int kvh = ub & 1, t0 = (ub >> 1) * 64;
            int sbase, T;
            if (t0 < T_PROMPT) { sbase = 0; T = T_PROMPT; } else if (t0 < 2 * T_PROMPT) { sbase = T_PROMPT; T = T_PROMPT; }
            else if (t0 < 2 * T_PROMPT + T_SAMPLE) { sbase = 2 * T_PROMPT; T = T_SAMPLE; } else { sbase = 2 * T_PROMPT + T_SAMPLE; T = T_SAMPLE; }
            const int b = (t0 - sbase) / 64, nb = T / 64;
            const int jlo_u = (2 - b) > 0 ? (2 - b) : 0, jhi_u = (nb + 1 - b) < 4 ? (nb + 1 - b) : 4;
            const bf16_t* Kg = QKV + (long)(sbase + 64 * (b - 2)) * NQKV + 2816 + kvh * 64; const bf16_t* Vg = Kg + 128;
            att::stage_kv<5>(lds, Kg, Vg, (long)NQKV, 64 * jlo_u, 64 * jhi_u + 64, tid);
            __syncthreads();
            {
                const int w = wave, h = kvh * 4 + (w >> 1), half = w & 1;
                const float slope = fast_exp2(-(float)(h + 1));
                const bf16_t* Qg = QKV + (long)(sbase + 64 * b + 32 * half) * NQKV + 2304 + h * 64;
                f32x16 o0, o1; float l;
                att::attn_task<128>(lds, Qg, (long)NQKV, jlo_u, jhi_u, 128 + 32 * half, -slope * LOG2E, -shiftB, o0, o1, l);
                const float extra = fast_exp2(b_sink[h] * LOG2E - shiftB);
                att::attn_store(lds, o0, o1, l, extra, Y + (long)(sbase + 64 * b + 32 * half) * NY + 256 + h * 64, (long)NY, w);
            }
            __syncthreads();
        }
        if (BOTH(4)) GRID_BAR();
    }
    if (IN(5)) {
        STAMP(5);
        const int gt = vcu * (NWAVES * 64) + tid, NT = G * NWAVES * 64;
        for (int idx = gt; idx < NTOK * 32; idx += NT) {
            const int tok = idx >> 5, part = idx & 31, sl = part >> 3, dch = part & 7;
            const float l0 = ltab[(size_t)tok * 12 + sl], l1 = ltab[(size_t)tok * 12 + 4 + sl], l2 = ltab[(size_t)tok * 12 + 8 + sl];
            const float inv = fast_rcp(l0 + l1 + l2); const float a0 = l0 * inv, a1 = l1 * inv, a2 = l2 * inv;
            const bf16_t* p = QKV + (size_t)tok * NQKV + sl * 64 + dch * 8;
            const u32x4 x0 = *(const u32x4*)p, x1 = *(const u32x4*)(p + 256), x2 = *(const u32x4*)(p + 512);
            u32x4 o;
#pragma unroll
            for (int i = 0; i < 4; ++i) o[i] = cvtpk(a0 * bf_lo(x0[i]) + a1 * bf_lo(x1[i]) + a2 * bf_lo(x2[i]), a0 * bf_hi(x0[i]) + a1 * bf_hi(x1[i]) + a2 * bf_hi(x2[i]));
            *(u32x4*)(Y + (size_t)tok * NY + sl * 64 + dch * 8) = o;
        }
        if (BOTH(5)) GRID_BAR();
    }
    if (IN(6)) {
        STAMP(6);
        { pg8::Gemm g{Y, Wpa_t, NTOK, DM, 256, NY}; pg8::StaticOrder S; S.init(NTOK, DM, G, bx); pg8::EpiPlain E{PA, DM}; pg8::gemm_phase(lds, g, S, E); }
        { pg8::Gemm g{Y + 256, Wpb_t, NTOK, DM, 512, NY}; pg8::StaticOrder S; S.init(NTOK, DM, G, bx); pg8::EpiPlain E{PB, DM}; pg8::gemm_phase(lds, g, S, E); }
        if (BOTH(6)) GRID_BAR();
    }
    if (IN(7)) {
        STAMP(7);
        pg8::Gemm g{HB, Wgate_t, NTOK, 2 * DM, DM, DM}; pg8::StaticOrder S; S.init(NTOK, 2 * DM, G, bx);
        pg8::EpiGate E{MB, ssq1, b_gate, PA, PB};
        pg8::gemm_phase(lds, g, S, E);
        if (BOTH(7)) GRID_BAR();
    }
    if (IN(8)) {
        STAMP(8);
        pg8::Gemm g{MB, Wout_t, NTOK, DM, DM, DM}; pg8::StaticOrder S; S.init(NTOK, DM, G, bx);
        pg8::EpiRes<false> E{HB, nullptr, ssq2, 1.0f};
        pg8::gemm_phase(lds, g, S, E);
        if (BOTH(8)) GRID_BAR();
    }
    if (IN(9)) {
        STAMP(9);
        pg8::Gemm g{HB, W2gu_t, NTOK, 2 * DFF, DM, DM}; pg8::StaticOrder S; S.init(NTOK, 2 * DFF, G, bx);
        pg8::EpiSwiGLU E{ACT, ssq2};
        pg8::gemm_phase(lds, g, S, E);
        if (BOTH(9)) GRID_BAR();
    }
    if (IN(10)) {
        STAMP(10);
        pg8::Gemm g{ACT, W2d_t, NTOK, DM, DFF, DFF}; pg8::StaticOrder S; S.init(NTOK, DM, G, bx);
        pg8::EpiRes<true> E{HB, out, ssq3, 0.5f};
        pg8::gemm_phase(lds, g, S, E);
        if (BOTH(10)) GRID_BAR();
    }
    if (IN(11)) {
        STAMP(11);
        f32x4 gfin[4];
#pragma unroll
        for (int j = 0; j < 4; ++j) gfin[j] = ((const f32x4*)final_norm)[lane + 64 * j];
#if PROBE_ON
        GRID_BAR();
        float probe_scale = 1.0f, probe_x = 0.f;
        if (PROBE_A >= 0) { const unsigned t0 = __hip_atomic_load(ctl + 16 + (PROBE_A >= 0 ? PROBE_A : 0), RLX_AGENT), t1 = __hip_atomic_load(ctl + 17 + (PROBE_A >= 0 ? PROBE_A : 0), RLX_AGENT); probe_scale = 1.025f + (float)(t1 - t0) * 0.01f * (1.0f / 20000.0f); }
        if (PROBE_B >= 0) { const unsigned t0 = __hip_atomic_load(ctl + 16 + (PROBE_B >= 0 ? PROBE_B : 0), RLX_AGENT), t1 = __hip_atomic_load(ctl + 17 + (PROBE_B >= 0 ? PROBE_B : 0), RLX_AGENT); probe_x = 20.0f + (float)(t1 - t0) * 0.01f * 0.5f; }
#endif
        for (int m0 = gw * 4; m0 < NTOK; m0 += NGW * 4) {
            f32x4 v[4][4]; float sq[4];
            { const f32x4 t = ((const f32x4*)(ssq3 + (size_t)m0 * 16))[lane & 15];
              float a = (t[0] + t[1]) + (t[2] + t[3]); a += __shfl_xor(a, 1); a += __shfl_xor(a, 2);
#pragma unroll
              for (int q = 0; q < 4; ++q) sq[q] = __shfl(a, 4 * q); }
#pragma unroll
            for (int q = 0; q < 4; ++q)
#pragma unroll
                for (int j = 0; j < 4; ++j) v[q][j] = ((const f32x4*)(out + (size_t)(m0 + q) * DM))[lane + 64 * j];
#pragma unroll
            for (int q = 0; q < 4; ++q) { const float rr = fast_rsq(sq[q] * (1.0f / DM) + NORM_EPS);
#pragma unroll
                for (int j = 0; j < 4; ++j) { f32x4 o = v[q][j] * rr * gfin[j];
#if PROBE_ON
                    if (m0 + q >= NTOK_PROMPT) o = o * probe_scale;
                    if (PROBE_B >= 0 && m0 + q == 0 && lane == 0 && j == 0) o[0] = probe_x;
#endif
                    ((f32x4*)(out + (size_t)(m0 + q) * DM))[lane + 64 * j] = o; } }
        }
    }
#undef IN
#undef BOTH
}

extern "C" void kernel_launch(void* const* d_in, const int* in_sizes, int n_in, void* d_out, int out_size, void* d_ws, size_t ws_size, hipStream_t stream) {
    static int grid = 0;
    if (grid == 0) {
        if (n_in != 23 || out_size != NTOK * DM || ws_size < WS_END) { fprintf(stderr, "kernel_launch: unexpected problem (n_in %d, out %d, ws %zu); nothing launched\n", n_in, out_size, ws_size); grid = -1; return; }
        int dev = 0, cus = 0, per_cu = 0;
        if (hipGetDevice(&dev) != hipSuccess || hipDeviceGetAttribute(&cus, hipDeviceAttributeMultiprocessorCount, dev) != hipSuccess) { fprintf(stderr, "kernel_launch: device query failed\n"); grid = -1; return; }
        if (hipFuncSetAttribute((const void*)enc_fwd, hipFuncAttributeMaxDynamicSharedMemorySize, LDS_BYTES) != hipSuccess) { fprintf(stderr, "kernel_launch: hipFuncSetAttribute failed\n"); grid = -1; return; }
        if (hipOccupancyMaxActiveBlocksPerMultiprocessor(&per_cu, (const void*)enc_fwd, NWAVES * 64, LDS_BYTES) != hipSuccess || per_cu < 1)
            fprintf(stderr, "kernel_launch: note: occupancy query reports %d workgroups per CU\n", per_cu);
        (void)hipGetLastError();
        grid = cus;
    }
    if (grid < 0) return;
    if (hipMemsetAsync((char*)d_ws + WS_CTL, 0, CTL_ZERO_BYTES, stream) != hipSuccess) { fprintf(stderr, "kernel_launch: memset failed\n"); return; }
    Args a{};
    for (int i = 0; i < 23; ++i) a.in[i] = (const float*)d_in[i];
    a.out = (float*)d_out; a.ws = (unsigned char*)d_ws;
#if MK_ONE_LAUNCH
    a.ph_lo = 0; a.ph_hi = NPHASE;
    hipLaunchKernelGGL(enc_fwd, dim3(grid), dim3(NWAVES * 64), LDS_BYTES, stream, a);
#else
    for (int p = 0; p < NPHASE; ++p) { a.ph_lo = p; a.ph_hi = p + 1; hipLaunchKernelGGL(enc_fwd, dim3(grid), dim3(NWAVES * 64), LDS_BYTES, stream, a); }
#endif
    const hipError_t le = hipPeekAtLastError();
    if (le != hipSuccess) fprintf(stderr, "kernel_launch: launch failed: %s\n", hipGetErrorName(le));
}
```

```cpp
#include <hip/hip_runtime.h>
#include <cstdio>
#include <cstdint>

#ifndef MK_ONE_LAUNCH
#define MK_ONE_LAUNCH 1
#endif
#define PROBE_A -1
#define PROBE_B -1
#define PROBE_ON (PROBE_A >= 0 || PROBE_B >= 0)

#define GAS __attribute__((address_space(1)))
#define LAS __attribute__((address_space(3)))
typedef unsigned short bf16_t;
typedef short bf16x8 __attribute__((ext_vector_type(8)));
typedef short s16x4 __attribute__((ext_vector_type(4)));
typedef float f32x4 __attribute__((ext_vector_type(4)));
typedef float f32x16 __attribute__((ext_vector_type(16)));
typedef unsigned u32x4 __attribute__((ext_vector_type(4)));
typedef unsigned u32x2 __attribute__((ext_vector_type(2)));
typedef float f32x2_t __attribute__((ext_vector_type(2)));
typedef __bf16 bf16x2_t __attribute__((ext_vector_type(2)));

constexpr int DM = 1024, DFF = 2816, NTOK = 49152, NQKV = 3072, NY = 768;
constexpr int T_PROMPT = 8192, T_SAMPLE = 16384, NTOK_PROMPT = 16384;
constexpr float NORM_EPS = 1e-6f;
constexpr float LOG2E = 1.4426950408889634f;
constexpr float QSCALE = 0.125f * LOG2E;

__device__ __forceinline__ unsigned cvtpk(float lo, float hi) { f32x2_t v = {lo, hi}; bf16x2_t b = __builtin_convertvector(v, bf16x2_t); return __builtin_bit_cast(unsigned, b); }
__device__ __forceinline__ float bf_lo(unsigned u) { return __builtin_bit_cast(float, u << 16); }
__device__ __forceinline__ float bf_hi(unsigned u) { return __builtin_bit_cast(float, u & 0xffff0000u); }
__device__ __forceinline__ float fast_exp2(float x) { return __builtin_amdgcn_exp2f(x); }
__device__ __forceinline__ float fast_rcp(float x) { return __builtin_amdgcn_rcpf(x); }
__device__ __forceinline__ float fast_rsq(float x) { return __builtin_amdgcn_rsqf(x); }
__device__ __forceinline__ float sigmoidf_(float a) { return fast_rcp(1.0f + fast_exp2(-LOG2E * a)); }

namespace pg8 {
constexpr int BM = 256, BK = 64, HALF = 128, HTB = HALF * BK * 2, STAGE_BYTES = 8 * HTB, NXCD = 8, WGM = 8;
__host__ __device__ __forceinline__ int lds_byte(int r, int c) { const int st = (r >> 4) * 2 + (c >> 5), rr = r & 15, cc = c & 31, ob = rr * 64 + cc * 2; return st * 1024 + (ob ^ (((ob >> 9) & 1) << 5)); }
__host__ __device__ __forceinline__ void stage_rc(int b, int& R, int& C) { const int st = b / 1024, sb = b % 1024, swz = sb ^ (((sb >> 9) & 1) << 5); R = (st >> 1) * 16 + swz / 64; C = (st & 1) * 32 + (swz % 64) / 2; }

struct Unit { int pm, pn; };
struct Gemm { const bf16_t* A; const bf16_t* Bt; int M, N, K, lda; };

struct StaticOrder {
    int nM, nN, nwg, G, c;
    __device__ void init(int M, int N, int G_, int c_) { nM = M / BM; nN = N / BM; nwg = nM * nN; G = G_; c = c_; }
    __device__ bool next(int i, Unit& u) const {
        const long L = (long)i * G + c; if (L >= nwg) return false;
        int wgid = (int)L; { const int q = nwg / NXCD, r = nwg % NXCD, xcd = wgid % NXCD, off = wgid / NXCD; wgid = (xcd < r ? xcd * (q + 1) : r * (q + 1) + (xcd - r) * q) + off; }
        const int nig = WGM * nN, gid = wgid / nig, fm = gid * WGM, gsz = (nM - fm) < WGM ? (nM - fm) : WGM;
        u.pm = fm + ((wgid % nig) % gsz); u.pn = (wgid % nig) / gsz; return true;
    }
};

template <class Epi>
__device__ __forceinline__ void gemm_phase(LAS unsigned char* lds, const Gemm g, const StaticOrder& S, const Epi& E, unsigned* probe_slot = nullptr) {
#if PROBE_ON
    unsigned pr_k = 0, pr_e = 0, pr_t = (unsigned)__builtin_amdgcn_s_memrealtime();
#endif
    const int tid = threadIdx.x, wid = __builtin_amdgcn_readfirstlane(tid >> 6), lane = tid & 63, wr = wid >> 2, wc = wid & 3, fr = lane & 15, fq = lane >> 4;
    const int K = g.K, nt = K / BK, lda = g.lda;
    unsigned voffA[2], voffB[2];
#pragma unroll
    for (int i = 0; i < 2; ++i) { int R, C; stage_rc(tid * 16 + i * 8192, R, C); voffA[i] = (unsigned)(R * lda + C) * 2u; voffB[i] = (unsigned)(R * K + C) * 2u; }
    const size_t kstep = (size_t)(BK * 2);
    const size_t hstepA = (size_t)HALF * lda * 2, hstepB = (size_t)HALF * K * 2;
    const size_t tstepA = 2 * hstepA, tstepB = 2 * hstepB;
    const unsigned ldsw = (unsigned)wid * 1024u;
    const int aoff = lds_byte(wr * 64 + fr, fq * 8), boff = lds_byte(wc * 32 + fr, fq * 8);
#define PG8_SA(b, h) (((b) * 2 + (h)) * HTB)
#define PG8_SB(b, h) ((4 + (b) * 2 + (h)) * HTB)
#define PG8_STAGE(bufoff, gbase, voff) do { _Pragma("unroll") for (int _i = 0; _i < 2; ++_i) \
        __builtin_amdgcn_global_load_lds((const unsigned*)((const char*)(gbase) + (voff)[_i]), (LAS unsigned*)(lds + (bufoff) + ldsw + _i * 8192), 16, 0, 0); } while (0)
#define PG8_LDA(dst, b, h) do { _Pragma("unroll") for (int m = 0; m < 4; ++m) _Pragma("unroll") for (int k = 0; k < 2; ++k) dst[m][k] = *(const LAS bf16x8*)(lds + PG8_SA(b, h) + aoff + m * 2048 + k * 1024); } while (0)
#define PG8_LDB(dst, b, h) do { _Pragma("unroll") for (int n = 0; n < 2; ++n) _Pragma("unroll") for (int k = 0; k < 2; ++k) dst[n][k] = *(const LAS bf16x8*)(lds + PG8_SB(b, h) + boff + n * 2048 + k * 1024); } while (0)
#define PG8_MMA(ai, bj, At, Bt) do { __builtin_amdgcn_s_setprio(1); _Pragma("unroll") for (int m = 0; m < 4; ++m) _Pragma("unroll") for (int n = 0; n < 2; ++n) _Pragma("unroll") for (int k = 0; k < 2; ++k) \
        acc[ai][bj][m][n] = __builtin_amdgcn_mfma_f32_16x16x32_bf16(Bt[n][k], At[m][k], acc[ai][bj][m][n], 0, 0, 0); __builtin_amdgcn_s_setprio(0); } while (0)
#define PG8_WAIT_V(n) asm volatile("s_waitcnt vmcnt(" #n ")" ::: "memory")
#define PG8_WAIT_L(n) asm volatile("s_waitcnt lgkmcnt(" #n ")" ::: "memory")
#define PG8_BAR __builtin_amdgcn_s_barrier()
#define PG8_SCHED __builtin_amdgcn_sched_barrier(0)
    Unit cur, nxt; int ui = 0;
    if (!S.next(0, cur)) return;
    f32x4 acc[2][2][4][2];
#pragma unroll
    for (int a = 0; a < 2; ++a)
#pragma unroll
        for (int b = 0; b < 2; ++b)
#pragma unroll
            for (int m = 0; m < 4; ++m)
#pragma unroll
                for (int n = 0; n < 2; ++n) acc[a][b][m][n] = (f32x4){0.f, 0.f, 0.f, 0.f};
    bf16x8 At[4][2], B0[2][2], B1[2][2];
    const char* cA = (const char*)g.A + (size_t)cur.pm * tstepA; const char* cB = (const char*)g.Bt + (size_t)cur.pn * tstepB;
    PG8_STAGE(PG8_SB(0, 0), cB, voffB); PG8_STAGE(PG8_SB(0, 1), cB + hstepB, voffB); PG8_STAGE(PG8_SA(0, 0), cA, voffA); PG8_STAGE(PG8_SA(0, 1), cA + hstepA, voffA);
    if (wr == 1) PG8_BAR;
    PG8_WAIT_V(2); PG8_BAR;
    PG8_STAGE(PG8_SB(1, 0), cB + kstep, voffB); PG8_STAGE(PG8_SA(1, 0), cA + kstep, voffA); PG8_STAGE(PG8_SB(1, 1), cB + hstepB + kstep, voffB);
    PG8_WAIT_V(6); PG8_BAR;
    for (;;) {
        const bool has_next = S.next(ui + 1, nxt);
        const char* nA = has_next ? (const char*)g.A + (size_t)nxt.pm * tstepA : cA; const char* nB = has_next ? (const char*)g.Bt + (size_t)nxt.pn * tstepB : cB;
        for (int t = 0; t < nt; t += 2) {
            const bool last = (t == nt - 2);
            const char* a1 = cA + (size_t)(t + 1) * kstep;
            const char* a2 = last ? nA : cA + (size_t)(t + 2) * kstep; const char* b2 = last ? nB : cB + (size_t)(t + 2) * kstep;
            const char* a3 = a2 + kstep; const char* b3 = b2 + kstep;
            PG8_LDB(B0, 0, 0); PG8_LDB(B1, 0, 1); PG8_SCHED; PG8_LDA(At, 0, 0); PG8_STAGE(PG8_SA(1, 1), a1 + hstepA, voffA);
            PG8_WAIT_V(8); PG8_WAIT_L(0); PG8_BAR; PG8_MMA(0, 0, At, B0); PG8_MMA(0, 1, At, B1); PG8_BAR; PG8_SCHED;
            PG8_LDA(At, 0, 1); PG8_STAGE(PG8_SB(0, 0), b2, voffB); PG8_STAGE(PG8_SB(0, 1), b2 + hstepB, voffB); PG8_STAGE(PG8_SA(0, 0), a2, voffA);
            PG8_WAIT_V(8); PG8_WAIT_L(0); PG8_BAR; PG8_MMA(1, 0, At, B0); PG8_MMA(1, 1, At, B1); PG8_BAR; PG8_SCHED;
            PG8_LDB(B0, 1, 0); PG8_LDB(B1, 1, 1); PG8_SCHED; PG8_LDA(At, 1, 0); PG8_STAGE(PG8_SA(0, 1), a2 + hstepA, voffA);
            PG8_WAIT_V(8); PG8_WAIT_L(0); PG8_BAR; PG8_MMA(0, 0, At, B0); PG8_MMA(0, 1, At, B1); PG8_BAR; PG8_SCHED;
            PG8_LDA(At, 1, 1); PG8_STAGE(PG8_SB(1, 0), b3, voffB); PG8_STAGE(PG8_SB(1, 1), b3 + hstepB, voffB); PG8_STAGE(PG8_SA(1, 0), a3, voffA);
            PG8_WAIT_V(8); PG8_WAIT_L(0); PG8_BAR; PG8_MMA(1, 0, At, B0); PG8_MMA(1, 1, At, B1); PG8_BAR; PG8_SCHED;
        }
        if (wr == 0) PG8_BAR;
#if PROBE_ON
        { const unsigned t = (unsigned)__builtin_amdgcn_s_memrealtime(); pr_k += t - pr_t; pr_t = t; }
#endif
        E(acc, cur, wr, wc, fr, fq, lane);
#if PROBE_ON
        { const unsigned t = (unsigned)__builtin_amdgcn_s_memrealtime(); pr_e += t - pr_t; pr_t = t; }
#endif
        if (!has_next) break;
#pragma unroll
        for (int a = 0; a < 2; ++a)
#pragma unroll
            for (int b = 0; b < 2; ++b)
#pragma unroll
                for (int m = 0; m < 4; ++m)
#pragma unroll
                    for (int n = 0; n < 2; ++n) acc[a][b][m][n] = (f32x4){0.f, 0.f, 0.f, 0.f};
        cur = nxt; cA = nA; cB = nB; ++ui;
        if (wr == 1) PG8_BAR;
    }
    PG8_WAIT_V(0);
    PG8_BAR;
#if PROBE_ON
    if (probe_slot && blockIdx.x == 0 && threadIdx.x == 0) { __hip_atomic_store(probe_slot, pr_k, __ATOMIC_RELAXED, __HIP_MEMORY_SCOPE_AGENT); __hip_atomic_store(probe_slot + 1, pr_e, __ATOMIC_RELAXED, __HIP_MEMORY_SCOPE_AGENT); }
#endif
#undef PG8_SA
#undef PG8_SB
#undef PG8_STAGE
#undef PG8_LDA
#undef PG8_LDB
#undef PG8_MMA
#undef PG8_WAIT_V
#undef PG8_WAIT_L
#undef PG8_BAR
#undef PG8_SCHED
}

struct RowRsCache { int pm; float r0, r1; };
__device__ __forceinline__ void row_rs(const float* ssq, int pm, int wr, int lane, float& r0, float& r1) {
    const f32x4* p0 = (const f32x4*)(ssq + (size_t)(pm * BM + wr * 64 + lane) * 16); const f32x4* p1 = p0 + HALF * 4;
    const f32x4 a0 = p0[0], a1 = p0[1], a2 = p0[2], a3 = p0[3], b0 = p1[0], b1 = p1[1], b2 = p1[2], b3 = p1[3];
    const f32x4 sa = (a0 + a1) + (a2 + a3), sb = (b0 + b1) + (b2 + b3);
    r0 = fast_rsq(((sa[0] + sa[1]) + (sa[2] + sa[3])) * (1.0f / DM) + NORM_EPS);
    r1 = fast_rsq(((sb[0] + sb[1]) + (sb[2] + sb[3])) * (1.0f / DM) + NORM_EPS);
}

struct EpiSwiGLU {
    bf16_t* O; const float* ssq; mutable RowRsCache rc; int pn_off;
    __device__ __forceinline__ void operator()(const f32x4 (&acc)[2][2][4][2], const Unit& u, int wr, int wc, int fr, int fq, int lane) const {
        if (u.pm != rc.pm) { row_rs(ssq, u.pm, wr, lane, rc.r0, rc.r1); rc.pm = u.pm; }
        const float r0 = rc.r0, r1 = rc.r1;
        const int col0 = (u.pn + pn_off) * 128 + wc * 32 + fq * 8;
#pragma unroll
        for (int ai = 0; ai < 2; ++ai)
#pragma unroll
            for (int m = 0; m < 4; ++m) {
                const float rr = __shfl(ai ? r1 : r0, 16 * m + fr);
                const size_t row = (size_t)(u.pm * BM + ai * HALF + wr * 64 + m * 16 + fr);
                float o[8];
#pragma unroll
                for (int bj = 0; bj < 2; ++bj)
#pragma unroll
                    for (int e = 0; e < 4; ++e) { const float gt = acc[ai][bj][m][0][e] * rr, up = acc[ai][bj][m][1][e] * rr;
                        o[bj * 4 + e] = gt * up * fast_rcp(1.0f + fast_exp2(-LOG2E * gt)); }
                u32x4 w; w.x = cvtpk(o[0], o[1]); w.y = cvtpk(o[2], o[3]); w.z = cvtpk(o[4], o[5]); w.w = cvtpk(o[6], o[7]);
                *(u32x4*)(O + row * DFF + col0) = w;
            }
    }
};

template <bool F32OUT> struct EpiRes {
    bf16_t* hb; float* out; float* ssq; float scale;
    __device__ __forceinline__ void operator()(const f32x4 (&acc)[2][2][4][2], const Unit& u, int wr, int wc, int fr, int fq, int lane) const {
        const int col0 = u.pn * BM + wc * 64 + 16 * fq;
        const size_t rowb = (size_t)(u.pm * BM + wr * 64 + fr);
#pragma unroll
        for (int ai = 0; ai < 2; ++ai) {
            u32x4 rs[2][4][2];
#pragma unroll
            for (int m = 0; m < 4; ++m)
#pragma unroll
                for (int bj = 0; bj < 2; ++bj) rs[ai][m][bj] = *(const u32x4*)(hb + (rowb + ai * HALF + m * 16) * DM + col0 + bj * 8);
#pragma unroll
            for (int m = 0; m < 4; ++m) {
                const size_t row = rowb + ai * HALF + m * 16; const size_t off = row * DM + col0;
                float ss = 0.f;
#pragma unroll
                for (int bj = 0; bj < 2; ++bj) { const u32x4 r = rs[ai][m][bj]; const f32x4 a0 = acc[ai][bj][m][0] * scale, a1 = acc[ai][bj][m][1] * scale;
                    f32x4 v0, v1; v0[0] = bf_lo(r[0]) + a0[0]; v0[1] = bf_hi(r[0]) + a0[1]; v0[2] = bf_lo(r[1]) + a0[2]; v0[3] = bf_hi(r[1]) + a0[3];
                    v1[0] = bf_lo(r[2]) + a1[0]; v1[1] = bf_hi(r[2]) + a1[1]; v1[2] = bf_lo(r[3]) + a1[2]; v1[3] = bf_hi(r[3]) + a1[3];
                    ss += ((v0[0] * v0[0] + v0[1] * v0[1]) + (v0[2] * v0[2] + v0[3] * v0[3])) + ((v1[0] * v1[0] + v1[1] * v1[1]) + (v1[2] * v1[2] + v1[3] * v1[3]));
                    if (F32OUT) { *(f32x4*)(out + off + bj * 8) = v0; *(f32x4*)(out + off + bj * 8 + 4) = v1; }
                    else { u32x4 w; w.x = cvtpk(v0[0], v0[1]); w.y = cvtpk(v0[2], v0[3]); w.z = cvtpk(v1[0], v1[1]); w.w = cvtpk(v1[2], v1[3]); *(u32x4*)(hb + off + bj * 8) = w; } }
                ss += __shfl_xor(ss, 16); ss += __shfl_xor(ss, 32);
                if (fq == 0) ssq[row * 16 + u.pn * 4 + wc] = ss;
            }
            asm volatile("" ::: "memory");
        }
    }
};

struct EpiQKV {
    bf16_t* O; const float* ssq; const float *gaq, *gak, *gbq, *gbk; mutable RowRsCache rc;
    __device__ __forceinline__ void operator()(const f32x4 (&acc)[2][2][4][2], const Unit& u, int wr, int wc, int fr, int fq, int lane) const {
        if (u.pm != rc.pm) { row_rs(ssq, u.pm, wr, lane, rc.r0, rc.r1); rc.pm = u.pm; }
        const float r0 = rc.r0, r1 = rc.r1;
        const float* gp = nullptr; float qs = 1.0f;
        if (u.pn < 3) { gp = gaq; qs = QSCALE; } else if (u.pn < 6) { gp = gak; } else if (u.pn < 9) { gp = nullptr; } else if (u.pn < 11) { gp = gbq; qs = QSCALE; } else if (wc < 2) { gp = gbk; }
        float gn[16];
#pragma unroll
        for (int i = 0; i < 16; ++i) gn[i] = 1.0f;
        if (gp) {
#pragma unroll
            for (int i = 0; i < 4; ++i) { const f32x4 t = *(const f32x4*)(gp + 16 * fq + 4 * i); gn[4 * i] = t[0] * qs; gn[4 * i + 1] = t[1] * qs; gn[4 * i + 2] = t[2] * qs; gn[4 * i + 3] = t[3] * qs; }
        }
        const int col0 = u.pn * BM + wc * 64 + fq * 16;
#pragma unroll
        for (int ai = 0; ai < 2; ++ai)
#pragma unroll
            for (int m = 0; m < 4; ++m) {
                const float rr = __shfl(ai ? r1 : r0, 16 * m + fr);
                const size_t row = (size_t)(u.pm * BM + ai * HALF + wr * 64 + m * 16 + fr);
                float v[16]; float ss = 0.f;
#pragma unroll
                for (int bj = 0; bj < 2; ++bj)
#pragma unroll
                    for (int n = 0; n < 2; ++n)
#pragma unroll
                        for (int e = 0; e < 4; ++e) { const float x = acc[ai][bj][m][n][e] * rr; v[bj * 8 + n * 4 + e] = x; ss += x * x; }
                ss += __shfl_xor(ss, 16); ss += __shfl_xor(ss, 32);
                const float hr = gp ? fast_rsq(ss * (1.0f / 64.0f) + NORM_EPS) : 1.0f;
#pragma unroll
                for (int i = 0; i < 16; ++i) v[i] = v[i] * hr * gn[i];
                u32x4 w0, w1; w0.x = cvtpk(v[0], v[1]); w0.y = cvtpk(v[2], v[3]); w0.z = cvtpk(v[4], v[5]); w0.w = cvtpk(v[6], v[7]);
                w1.x = cvtpk(v[8], v[9]); w1.y = cvtpk(v[10], v[11]); w1.z = cvtpk(v[12], v[13]); w1.w = cvtpk(v[14], v[15]);
                bf16_t* p = O + row * NQKV + col0; *(u32x4*)p = w0; *(u32x4*)(p + 8) = w1;
            }
    }
};

struct EpiPlain {
    bf16_t* O; int ldc;
    __device__ __forceinline__ void operator()(const f32x4 (&acc)[2][2][4][2], const Unit& u, int wr, int wc, int fr, int fq, int lane) const {
        const int col0 = u.pn * BM + wc * 32 + fq * 8;
#pragma unroll
        for (int ai = 0; ai < 2; ++ai)
#pragma unroll
            for (int m = 0; m < 4; ++m) {
                const size_t row = (size_t)(u.pm * BM + ai * HALF + wr * 64 + m * 16 + fr);
#pragma unroll
                for (int bj = 0; bj < 2; ++bj) { const f32x4 v0 = acc[ai][bj][m][0], v1 = acc[ai][bj][m][1];
                    u32x4 w; w.x = cvtpk(v0[0], v0[1]); w.y = cvtpk(v0[2], v0[3]); w.z = cvtpk(v1[0], v1[1]); w.w = cvtpk(v1[2], v1[3]);
                    *(u32x4*)(O + row * ldc + col0 + bj * HALF) = w; }
            }
    }
};

struct EpiGate {
    bf16_t* O; const float* ssq; const float* bgate; const bf16_t* PA; const bf16_t* PB; mutable RowRsCache rc;
    __device__ __forceinline__ void operator()(const f32x4 (&acc)[2][2][4][2], const Unit& u, int wr, int wc, int fr, int fq, int lane) const {
        if (u.pm != rc.pm) { row_rs(ssq, u.pm, wr, lane, rc.r0, rc.r1); rc.pm = u.pm; }
        const float r0 = rc.r0, r1 = rc.r1;
        const int col0 = u.pn * 128 + wc * 32 + fq * 8;
        float ba[8], bb[8];
        { const f32x4 t0 = *(const f32x4*)(bgate + col0), t1 = *(const f32x4*)(bgate + col0 + 4), t2 = *(const f32x4*)(bgate + DM + col0), t3 = *(const f32x4*)(bgate + DM + col0 + 4);
#pragma unroll
          for (int e = 0; e < 4; ++e) { ba[e] = t0[e]; ba[4 + e] = t1[e]; bb[e] = t2[e]; bb[4 + e] = t3[e]; } }
#pragma unroll
        for (int ai = 0; ai < 2; ++ai) {
            u32x4 pas[2][4], pbs[2][4];
#pragma unroll
            for (int m = 0; m < 4; ++m) { const size_t row = (size_t)(u.pm * BM + ai * HALF + wr * 64 + m * 16 + fr);
                pas[ai][m] = *(const u32x4*)(PA + row * DM + col0); pbs[ai][m] = *(const u32x4*)(PB + row * DM + col0); }
#pragma unroll
            for (int m = 0; m < 4; ++m) {
                const float rr = __shfl(ai ? r1 : r0, 16 * m + fr);
                const size_t row = (size_t)(u.pm * BM + ai * HALF + wr * 64 + m * 16 + fr);
                const u32x4 pa = pas[ai][m], pb = pbs[ai][m];
                float o[8];
#pragma unroll
                for (int bj = 0; bj < 2; ++bj)
#pragma unroll
                    for (int e = 0; e < 4; ++e) { const int i = bj * 4 + e;
                        const float ga = sigmoidf_(acc[ai][bj][m][0][e] * rr + ba[i]), gb = sigmoidf_(acc[ai][bj][m][1][e] * rr + bb[i]);
                        const unsigned wa = pa[i >> 1], wb = pb[i >> 1];
                        const float xa = (i & 1) ? bf_hi(wa) : bf_lo(wa), xb = (i & 1) ? bf_hi(wb) : bf_lo(wb);
                        o[i] = ga * xa + gb * xb; }
                u32x4 w; w.x = cvtpk(o[0], o[1]); w.y = cvtpk(o[2], o[3]); w.z = cvtpk(o[4], o[5]); w.w = cvtpk(o[6], o[7]);
                *(u32x4*)(O + row * DM + col0) = w;
            }
            asm volatile("" ::: "memory");
        }
    }
};
}

namespace att {
constexpr int KPL = 6144 + 16, VPL = 24576 + 64;
constexpr int OFF_K = 0, OFF_V = 8 * KPL, OFF_WS = OFF_V + 2 * VPL, OFF_OST = OFF_WS + 8 * 256, LDS_BYTES = OFF_OST + 8 * 4096;
__device__ __forceinline__ int crow(int r, int hi) { return (r & 3) + 8 * (r >> 2) + 4 * hi; }
__device__ __forceinline__ s16x4 vtr(const LAS unsigned char* p) { return __builtin_bit_cast(s16x4, __builtin_amdgcn_ds_read_tr16_b64_v4i16((LAS s16x4*)p)); }

struct KVSrc { const bf16_t* Kg; const bf16_t* Vg; long rstride; int row_lo, row_hi; };
template <int NIT>
__device__ __forceinline__ void load_kv(const KVSrc& src, u32x4 (&kv)[NIT], u32x4 (&vv)[NIT], int tid) {
#pragma unroll
    for (int it = 0; it < NIT; ++it) { const int q = tid + it * 512, row = q >> 3, c = q & 7;
        if (row >= src.row_lo && row < src.row_hi) { kv[it] = *(const u32x4*)(src.Kg + (long)row * src.rstride + c * 8); vv[it] = *(const u32x4*)(src.Vg + (long)row * src.rstride + c * 8); } }
}
template <int NIT>
__device__ __forceinline__ void write_kv(LAS unsigned char* lds, const KVSrc& src, const u32x4 (&kv)[NIT], const u32x4 (&vv)[NIT], int tid) {
#pragma unroll
    for (int it = 0; it < NIT; ++it) { const int q = tid + it * 512, row = q >> 3, c = q & 7;
        if (row >= src.row_lo && row < src.row_hi) { *(LAS u32x4*)(lds + OFF_K + c * KPL + row * 16) = kv[it]; *(LAS u32x4*)(lds + OFF_V + (c >> 2) * VPL + row * 64 + (c & 3) * 16) = vv[it]; } }
}
__device__ __forceinline__ void load_q(const bf16_t* Qg, long qstride, bf16x8 (&qr)[4]) {
    const int lane = threadIdx.x & 63, r32 = lane & 31, hi = lane >> 5;
#pragma unroll
    for (int d0 = 0; d0 < 4; ++d0) qr[d0] = *(const bf16x8*)(Qg + (long)r32 * qstride + d0 * 16 + hi * 8);
}

template <int HW, bool MASK>
__device__ __forceinline__ void attn_tile(const LAS unsigned char* kt, const LAS unsigned char* vt, const bf16x8 (&qr)[4], float basef, float nslope2, f32x16& oa, f32x16& ob, float& l) {
    f32x16 p0 = {}, p1 = {};
#pragma unroll
    for (int d0 = 0; d0 < 4; ++d0) { const bf16x8 b0 = *(const LAS bf16x8*)(kt + 2 * d0 * KPL), b1 = *(const LAS bf16x8*)(kt + 2 * d0 * KPL + 512);
        p0 = __builtin_amdgcn_mfma_f32_32x32x16_bf16(b0, qr[d0], p0, 0, 0, 0); p1 = __builtin_amdgcn_mfma_f32_32x32x16_bf16(b1, qr[d0], p1, 0, 0, 0); }
    float s = 0.f;
#pragma unroll
    for (int r = 0; r < 16; ++r) { const float cc = (float)((r & 3) + 8 * (r >> 2));
        const float a0 = __builtin_fabsf(basef - cc), a1 = __builtin_fabsf(basef - cc - 32.0f);
        float v0 = __builtin_fmaf(a0, nslope2, p0[r]), v1 = __builtin_fmaf(a1, nslope2, p1[r]);
        if (MASK) { v0 = (a0 <= (float)HW) ? v0 : -INFINITY; v1 = (a1 <= (float)HW) ? v1 : -INFINITY; }
        p0[r] = fast_exp2(v0); p1[r] = fast_exp2(v1); s += p0[r] + p1[r]; }
    l += s;
    u32x4 pw[4];
#pragma unroll
    for (int i = 0; i < 4; ++i) { pw[0][i] = cvtpk(p0[2 * i], p0[2 * i + 1]); pw[1][i] = cvtpk(p0[8 + 2 * i], p0[9 + 2 * i]); pw[2][i] = cvtpk(p1[2 * i], p1[2 * i + 1]); pw[3][i] = cvtpk(p1[8 + 2 * i], p1[9 + 2 * i]); }
#pragma unroll
    for (int ks = 0; ks < 4; ++ks) {
        const s16x4 lo0 = vtr(vt + ks * 1024), hi0 = vtr(vt + ks * 1024 + 512), lo1 = vtr(vt + VPL + ks * 1024), hi1 = vtr(vt + VPL + ks * 1024 + 512);
        const bf16x8 pa = __builtin_bit_cast(bf16x8, pw[ks]);
        const bf16x8 v0 = (bf16x8){lo0[0], lo0[1], lo0[2], lo0[3], hi0[0], hi0[1], hi0[2], hi0[3]}, v1 = (bf16x8){lo1[0], lo1[1], lo1[2], lo1[3], hi1[0], hi1[1], hi1[2], hi1[3]};
        oa = __builtin_amdgcn_mfma_f32_32x32x16_bf16(pa, v0, oa, 0, 0, 0); ob = __builtin_amdgcn_mfma_f32_32x32x16_bf16(pa, v1, ob, 0, 0, 0);
    }
}

template <int HW>
__device__ __forceinline__ void attn_task(LAS unsigned char* lds, const bf16x8 (&qr)[4], int jlo, int jhi, int jfull_lo, int jfull_hi, int qoff, float nslope2, f32x16& o0, f32x16& o1, float& lsum) {
    const int lane = threadIdx.x & 63, r32 = lane & 31, hi = lane >> 5;
    const LAS unsigned char* kp = lds + OFF_K + hi * KPL + r32 * 16;
    const LAS unsigned char* vp = lds + OFF_V + ((lane >> 4) & 1) * 32 + (lane & 3) * 8 + (4 * hi + ((lane & 15) >> 2)) * 64;
    f32x16 oa = {}, ob = {}; float l = 0.f;
    for (int j = jlo; j <= jhi; ++j) {
        const float basef = (float)(qoff + r32 - 64 * j - 4 * hi);
        attn_tile<HW, true>(kp + j * 1024, vp + j * 4096, qr, basef, nslope2, oa, ob, l);
    }
    l += __shfl_xor(l, 32);
    o0 = oa; o1 = ob; lsum = l;
}

__device__ __forceinline__ void attn_store(LAS unsigned char* lds, const f32x16& o0, const f32x16& o1, float l, float extra, bf16_t* Og, long ostride, int wid) {
    const int lane = threadIdx.x & 63, r32 = lane & 31, hi = lane >> 5;
    LAS float* wsf = (LAS float*)(lds + OFF_WS + wid * 256);
    if (hi == 0) wsf[r32] = fast_rcp(l + extra);
    LAS bf16_t* stg = (LAS bf16_t*)(lds + OFF_OST + wid * 4096);
#pragma unroll
    for (int r = 0; r < 16; ++r) { const int orow = crow(r, hi); const float rl = wsf[orow];
        const unsigned a = cvtpk(o0[r] * rl, 0.f), b = cvtpk(o1[r] * rl, 0.f);
        stg[orow * 64 + r32] = (bf16_t)(a & 0xffffu); stg[orow * 64 + 32 + r32] = (bf16_t)(b & 0xffffu); }
#pragma unroll
    for (int i = 0; i < 4; ++i) { const int row = i * 8 + (lane >> 3), ch = lane & 7; const u32x4 v = *(const LAS u32x4*)(stg + row * 64 + ch * 8); *(u32x4*)(Og + (long)row * ostride + ch * 8) = v; }
}
}

constexpr int NWAVES = 8;
constexpr int NPHASE = 12;
constexpr size_t MiB = 1u << 20;
constexpr size_t WS_CTL = 0, CTL_ZERO_BYTES = 1 * MiB;
constexpr size_t WS_SSQ0 = 1 * MiB, WS_SSQ1 = 4 * MiB, WS_SSQ2 = 7 * MiB, WS_SSQ3 = 10 * MiB;
constexpr size_t WS_LTAB = 13 * MiB;
constexpr size_t WS_WIN = 16 * MiB, WS_WGATE = 22 * MiB, WS_WPA = 26 * MiB, WS_WPB = 27 * MiB, WS_WOUT = 28 * MiB, WS_W2GU = 30 * MiB, WS_W2D = 41 * MiB;
constexpr size_t WS_HB = 47 * MiB;
constexpr size_t WS_W1GU = 143 * MiB, WS_W1D = 154 * MiB;
constexpr size_t WS_Y = 143 * MiB;
constexpr size_t WS_ACT = 160 * MiB;
constexpr size_t WS_QKV = 215 * MiB;
constexpr size_t WS_PA = 215 * MiB, WS_PB = 311 * MiB, WS_M = 407 * MiB;
constexpr size_t WS_END = 503 * MiB;
constexpr int CW_BAR = 4096;

constexpr int RING_BYTES = 134144;
constexpr int LDSCTL_OFF = RING_BYTES, MISC_OFF = LDSCTL_OFF + 320;
constexpr int LDS_BYTES = 147456;
static_assert(att::LDS_BYTES <= RING_BYTES && pg8::STAGE_BYTES <= RING_BYTES && MISC_OFF + 128 <= LDS_BYTES, "LDS map");

typedef GAS unsigned gu32;
#define RLX_AGENT __ATOMIC_RELAXED, __HIP_MEMORY_SCOPE_AGENT
#define LDS_WAIT() asm volatile("s_waitcnt lgkmcnt(0)" ::: "memory")

#define XB_TMO      128
#define XB_XCNT(j)  (256  + 64 * (j))
#define XB_XSUB(j)  (1280 + 64 * (j))
#define XB_XGEN(j)  (2304 + 64 * (j))
#define XB_TOP      3328
#define XB_TOPGEN   3392
#define XCD_BAR_WORDS 3456
#define XB_SPIN_CAP (1u << 18)
__device__ __forceinline__ unsigned xb_ld(unsigned* p)              { return __hip_atomic_load(p, __ATOMIC_RELAXED, __HIP_MEMORY_SCOPE_AGENT); }
__device__ __forceinline__ unsigned xb_add(unsigned* p, unsigned v) { return __hip_atomic_fetch_add(p, v, __ATOMIC_RELAXED, __HIP_MEMORY_SCOPE_AGENT); }
__device__ __forceinline__ unsigned xb_xcc_id() { return (unsigned)__builtin_amdgcn_s_getreg((3 << 11) | 20) & 0xFu; }
#define XB_SPIN(cond, bar) do { unsigned _sp = 0; while (cond) { __builtin_amdgcn_s_sleep(1); \
    if ((++_sp & 255u) == 0u) { if (xb_ld(&(bar)[XB_TMO])) break; if (_sp > XB_SPIN_CAP) { atomicAdd(&(bar)[XB_TMO], 1u); break; } } } } while (0)
struct XcdBarrier { unsigned* bar; unsigned x; volatile LAS unsigned* st; };
__device__ __forceinline__ XcdBarrier xcd_barrier_post(unsigned* bar, volatile LAS unsigned* st) {
    XcdBarrier b; b.bar = bar; b.x = xb_xcc_id(); b.st = st;
    if (threadIdx.x == 0) (void)xb_add(&bar[XB_XCNT(b.x)], 1u);
    return b;
}
__device__ __forceinline__ void xcd_barrier_complete(unsigned* bar, unsigned x, unsigned& nloc, unsigned& nx) {
    const unsigned G = gridDim.x * gridDim.y * gridDim.z;
    unsigned sum, cnt, mine, sp = 0u;
    for (;;) {
        sum = 0u; cnt = 0u; mine = 0u;
#pragma unroll
        for (unsigned j = 0; j < 16; ++j) { const unsigned c = xb_ld(&bar[XB_XCNT(j)]); sum += c; cnt += (c > 0u) ? 1u : 0u; mine = (j == x) ? c : mine; }
        if (sum == G) break;
        __builtin_amdgcn_s_sleep(1);
        if ((++sp & 255u) == 0u) { if (xb_ld(&bar[XB_TMO])) break; if (sp > XB_SPIN_CAP) { atomicAdd(&bar[XB_TMO], 1u); break; } }
    }
    nloc = mine > 0u ? mine : 1u; nx = cnt > 0u ? cnt : 1u;
}
__device__ __forceinline__ void xcd_barrier(const XcdBarrier& b) {
    asm volatile("s_waitcnt vmcnt(0)" ::: "memory");
    __syncthreads();
    if (threadIdx.x == 0) {
        unsigned* bar = b.bar;
        __builtin_amdgcn_s_waitcnt(0);
        unsigned nloc = b.st[0], nx = b.st[1];
        if (nloc == 0u) { xcd_barrier_complete(bar, b.x, nloc, nx); b.st[0] = nloc; b.st[1] = nx; }
        const unsigned old = xb_add(&bar[XB_XSUB(b.x)], 1u);
        const unsigned gen = old / nloc;
        if (old + 1u == (gen + 1u) * nloc) {
            __builtin_amdgcn_fence(__ATOMIC_RELEASE, "agent");
            asm volatile("s_waitcnt vmcnt(0)" ::: "memory");
            const unsigned og = xb_add(&bar[XB_TOP], 1u);
            const unsigned tg = og / nx;
            if (og + 1u == (tg + 1u) * nx) xb_add(&bar[XB_TOPGEN], 1u);
            else XB_SPIN(xb_ld(&bar[XB_TOPGEN]) == tg, bar);
            __builtin_amdgcn_fence(__ATOMIC_ACQUIRE, "agent");
            xb_add(&bar[XB_XGEN(b.x)], 1u);
            asm volatile("s_waitcnt vmcnt(0)" ::: "memory");
        } else {
            XB_SPIN(xb_ld(&bar[XB_XGEN(b.x)]) == gen, bar);
            __builtin_amdgcn_fence(__ATOMIC_ACQUIRE, "agent");
            asm volatile("s_waitcnt vmcnt(0)" ::: "memory");
        }
    }
    __syncthreads();
}

__device__ __forceinline__ float wave_sum(float v) {
#pragma unroll
    for (int o = 1; o < 64; o <<= 1) v += __shfl_xor(v, o);
    return v;
}
__device__ __forceinline__ float wave_max(float v) {
#pragma unroll
    for (int o = 1; o < 64; o <<= 1) v = __builtin_fmaxf(v, __shfl_xor(v, o));
    return v;
}

__device__ __forceinline__ int map_gu(int sel, int col) { const int pn = col >> 7, c = col & 127, wc = c >> 5, fq = (c >> 3) & 3, bj = (c >> 2) & 1, e = c & 3; return 256 * pn + 128 * bj + 32 * wc + 16 * sel + 4 * fq + e; }
__device__ __forceinline__ int map_head(int col) { const int pn = col >> 8, c = col & 255, wc = c >> 6, ch = c & 63, fq = ch >> 4, bj = (ch >> 3) & 1, n = (ch >> 2) & 1, e = ch & 3; return 256 * pn + 128 * bj + 32 * wc + 16 * n + 4 * fq + e; }
__device__ __forceinline__ int map_p8(int col) { const int pn = col >> 8, c = col & 255, bj = c >> 7, wc = (c >> 5) & 3, fq = (c >> 3) & 3, n = (c >> 2) & 1, e = c & 3; return 256 * pn + 128 * bj + 32 * wc + 16 * n + 4 * fq + e; }
template <int MAPK, bool GAIN>
__device__ __forceinline__ void transpose_item(const float* W, int K, int N, bf16_t* WT, const float* gain, LAS float* scr, int item, int lane, int coloff = 0) {
    const int nblk = N / 32, kb = item / nblk, nb = item % nblk, k0 = 64 * kb, n0 = 32 * nb;
    const int c = lane & 7;
    f32x4 g0 = {1.f, 1.f, 1.f, 1.f}, g1 = {1.f, 1.f, 1.f, 1.f};
    if (GAIN) { g0 = *(const f32x4*)(gain + k0 + 8 * c); g1 = *(const f32x4*)(gain + k0 + 8 * c + 4); }
    float t[32];
#pragma unroll
    for (int i = 0; i < 32; ++i) t[i] = W[(size_t)(k0 + 2 * i + (lane >> 5)) * N + n0 + (lane & 31)];
#pragma unroll
    for (int i = 0; i < 32; ++i) scr[(2 * i + (lane >> 5)) * 33 + (lane & 31)] = t[i];
    LDS_WAIT(); asm volatile("" ::: "memory");
#pragma unroll
    for (int j = 0; j < 4; ++j) { const int n = (lane >> 3) + 8 * j; const LAS float* s = scr + (8 * c) * 33 + n;
        u32x4 o; o.x = cvtpk(s[0 * 33] * g0[0], s[1 * 33] * g0[1]); o.y = cvtpk(s[2 * 33] * g0[2], s[3 * 33] * g0[3]); o.z = cvtpk(s[4 * 33] * g1[0], s[5 * 33] * g1[1]); o.w = cvtpk(s[6 * 33] * g1[2], s[7 * 33] * g1[3]);
        const int col = n0 + n - coloff;
        const int row = MAPK == 0 ? col : MAPK == 1 ? map_gu(0, col) : MAPK == 2 ? map_gu(1, col) : MAPK == 3 ? map_head(col) : map_p8(col);
        *(u32x4*)(WT + (size_t)row * K + k0 + 8 * c) = o; }
    LDS_WAIT(); asm volatile("" ::: "memory");
}

struct Args { const float* in[23]; float* out; unsigned char* ws; int ph_lo, ph_hi; };

__global__ void __launch_bounds__(NWAVES * 64, 2) enc_fwd(Args args) {
    extern __shared__ __attribute__((aligned(16))) unsigned char lds_raw[];
    LAS unsigned char* lds = (LAS unsigned char*)lds_raw;
    volatile LAS unsigned* MISC = (volatile LAS unsigned*)(lds + MISC_OFF);
    const int tid = threadIdx.x, lane = tid & 63, wave = __builtin_amdgcn_readfirstlane(tid >> 6);
    const int G = gridDim.x, bx = blockIdx.x;
    const int vcu = (G % 8 == 0) ? (bx % 8) * (G / 8) + bx / 8 : bx;
    unsigned char* ws = args.ws;
    gu32* ctl = (gu32*)(ws + WS_CTL);
    const float* x_prompt = args.in[0]; const float* x_sample = args.in[1];
    const float* ffn1_norm = args.in[2]; const float* ffn1_wg = args.in[3]; const float* ffn1_wu = args.in[4]; const float* ffn1_wd = args.in[5];
    const float* mix_norm = args.in[6]; const float* w_in = args.in[7];
    const float* a_q_norm = args.in[8]; const float* a_k_norm = args.in[9]; const float* b_q_norm = args.in[10]; const float* b_k_norm = args.in[11]; const float* b_sink = args.in[12];
    const float* w_proj_a = args.in[13]; const float* w_proj_b = args.in[14]; const float* w_gate = args.in[15]; const float* b_gate = args.in[16]; const float* w_out = args.in[17];
    const float* ffn2_norm = args.in[18]; const float* ffn2_wg = args.in[19]; const float* ffn2_wu = args.in[20]; const float* ffn2_wd = args.in[21]; const float* final_norm = args.in[22];
    float* out = args.out;
    float* ssq0 = (float*)(ws + WS_SSQ0); float* ssq1 = (float*)(ws + WS_SSQ1); float* ssq2 = (float*)(ws + WS_SSQ2); float* ssq3 = (float*)(ws + WS_SSQ3);
    float* ltab = (float*)(ws + WS_LTAB);
    bf16_t* Win_t = (bf16_t*)(ws + WS_WIN); bf16_t* Wgate_t = (bf16_t*)(ws + WS_WGATE); bf16_t* Wpa_t = (bf16_t*)(ws + WS_WPA); bf16_t* Wpb_t = (bf16_t*)(ws + WS_WPB); bf16_t* Wout_t = (bf16_t*)(ws + WS_WOUT);
    bf16_t* W1gu_t = (bf16_t*)(ws + WS_W1GU); bf16_t* W1d_t = (bf16_t*)(ws + WS_W1D); bf16_t* W2gu_t = (bf16_t*)(ws + WS_W2GU); bf16_t* W2d_t = (bf16_t*)(ws + WS_W2D);
    bf16_t* HB = (bf16_t*)(ws + WS_HB); bf16_t* ACT = (bf16_t*)(ws + WS_ACT); bf16_t* QKV = (bf16_t*)(ws + WS_QKV); bf16_t* Y = (bf16_t*)(ws + WS_Y);
    bf16_t* PA = (bf16_t*)(ws + WS_PA); bf16_t* PB = (bf16_t*)(ws + WS_PB); bf16_t* MB = (bf16_t*)(ws + WS_M);

    for (int u = tid; u < (LDS_BYTES - LDSCTL_OFF) / 4; u += NWAVES * 64) ((LAS unsigned*)(lds + LDSCTL_OFF))[u] = 0u;
    __syncthreads();
#if MK_ONE_LAUNCH
    XcdBarrier bar = xcd_barrier_post((unsigned*)(ctl + CW_BAR), MISC + 8);
#define GRID_BAR() xcd_barrier(bar)
#else
#define GRID_BAR() do { } while (0)
#endif
    const int lo = args.ph_lo, hi = args.ph_hi;
#define IN(k) (lo <= (k) && (k) < hi)
#define BOTH(k) (IN(k) && IN((k) + 1))
#if PROBE_ON
#define STAMP(k) do { if (bx == 0 && tid == 0) __hip_atomic_store(ctl + 16 + (k), (unsigned)__builtin_amdgcn_s_memrealtime(), RLX_AGENT); } while (0)
#else
#define STAMP(k) do { } while (0)
#endif
    const int gw = vcu * NWAVES + wave, NGW = G * NWAVES;

    if (IN(0)) {
        STAMP(0);
        LAS float* scr = (LAS float*)(lds + wave * 16384);
        constexpr int I_GU = (DM / 64) * (DFF / 32), I_D = (DFF / 64) * (DM / 32), I_IN = (DM / 64) * (NQKV / 32), I_GT = (DM / 64) * (2 * DM / 32), I_PA = (256 / 64) * (DM / 32), I_PB = (512 / 64) * (DM / 32), I_O = (DM / 64) * (DM / 32);
        constexpr int NITEMS = 4 * I_GU + 2 * I_D + I_IN + I_GT + I_PA + I_PB + I_O;
        for (int it = gw; it < NITEMS; it += NGW) {
            int r = it;
            if (r < I_GU) { transpose_item<1, true>(ffn1_wg, DM, DFF, W1gu_t, ffn1_norm, scr, r, lane); continue; } r -= I_GU;
            if (r < I_GU) { transpose_item<2, true>(ffn1_wu, DM, DFF, W1gu_t, ffn1_norm, scr, r, lane); continue; } r -= I_GU;
            if (r < I_D)  { transpose_item<3, false>(ffn1_wd, DFF, DM, W1d_t, nullptr, scr, r, lane); continue; } r -= I_D;
            if (r < I_IN) { transpose_item<3, true>(w_in, DM, NQKV, Win_t, mix_norm, scr, r, lane); continue; } r -= I_IN;
            if (r < I_GT) {
                if ((r % (2 * DM / 32)) < DM / 32) transpose_item<1, true>(w_gate, DM, 2 * DM, Wgate_t, mix_norm, scr, r, lane);
                else transpose_item<2, true>(w_gate, DM, 2 * DM, Wgate_t, mix_norm, scr, r, lane, DM);
                continue; } r -= I_GT;
            if (r < I_PA) { transpose_item<4, false>(w_proj_a, 256, DM, Wpa_t, nullptr, scr, r, lane); continue; } r -= I_PA;
            if (r < I_PB) { transpose_item<4, false>(w_proj_b, 512, DM, Wpb_t, nullptr, scr, r, lane); continue; } r -= I_PB;
            if (r < I_O)  { transpose_item<3, false>(w_out, DM, DM, Wout_t, nullptr, scr, r, lane); continue; } r -= I_O;
            if (r < I_GU) { transpose_item<1, true>(ffn2_wg, DM, DFF, W2gu_t, ffn2_norm, scr, r, lane); continue; } r -= I_GU;
            if (r < I_GU) { transpose_item<2, true>(ffn2_wu, DM, DFF, W2gu_t, ffn2_norm, scr, r, lane); continue; } r -= I_GU;
            transpose_item<3, false>(ffn2_wd, DFF, DM, W2d_t, nullptr, scr, r, lane);
        }
        for (int m0 = gw * 4; m0 < NTOK; m0 += NGW * 4) {
            const float* xrow = (m0 < NTOK_PROMPT) ? x_prompt + (size_t)m0 * DM : x_sample + (size_t)(m0 - NTOK_PROMPT) * DM;
            f32x4 v[4][4]; float sq[4];
#pragma unroll
            for (int q = 0; q < 4; ++q)
#pragma unroll
                for (int j = 0; j < 4; ++j) v[q][j] = ((const f32x4*)(xrow + (size_t)q * DM))[lane + 64 * j];
#pragma unroll
            for (int q = 0; q < 4; ++q) { float t = 0.f;
#pragma unroll
                for (int j = 0; j < 4; ++j) t += (v[q][j][0] * v[q][j][0] + v[q][j][1] * v[q][j][1]) + (v[q][j][2] * v[q][j][2] + v[q][j][3] * v[q][j][3]);
                sq[q] = t; }
#pragma unroll
            for (int o = 1; o < 64; o <<= 1) {
#pragma unroll
                for (int q = 0; q < 4; ++q) sq[q] += __shfl_xor(sq[q], o); }
#pragma unroll
            for (int q = 0; q < 4; ++q) { u32x2* o8 = (u32x2*)(HB + (size_t)(m0 + q) * DM) + lane;
#pragma unroll
                for (int j = 0; j < 4; ++j) { u32x2 w; w.x = cvtpk(v[q][j][0], v[q][j][1]); w.y = cvtpk(v[q][j][2], v[q][j][3]); o8[64 * j] = w; } }
            { const int q = lane >> 4, i = lane & 15; const float sv = (q == 0) ? sq[0] : (q == 1) ? sq[1] : (q == 2) ? sq[2] : sq[3]; ssq0[(size_t)(m0 + q) * 16 + i] = (i == 0) ? sv : 0.f; }
        }
        if (BOTH(0)) GRID_BAR();
    }
    if (IN(1)) {
        STAMP(1);
        pg8::Gemm g{HB, W1gu_t, NTOK, 2 * DFF, DM, DM}; pg8::StaticOrder S; S.init(NTOK, 2 * DFF, G, bx);
        pg8::EpiSwiGLU E{ACT, ssq0, {-1, 0.f, 0.f}, 0};
        pg8::gemm_phase(lds, g, S, E, (unsigned*)(ctl + 32 + 2 * 1));
        if (BOTH(1)) GRID_BAR();
    }
    if (IN(2)) {
        STAMP(2);
        pg8::Gemm g{ACT, W1d_t, NTOK, DM, DFF, DFF}; pg8::StaticOrder S; S.init(NTOK, DM, G, bx);
        pg8::EpiRes<false> E{HB, nullptr, ssq1, 0.5f};
        pg8::gemm_phase(lds, g, S, E, (unsigned*)(ctl + 32 + 2 * 2));
        if (BOTH(2)) GRID_BAR();
    }
    if (IN(3)) {
        STAMP(3);
        pg8::Gemm g{HB, Win_t, NTOK, NQKV, DM, DM}; pg8::StaticOrder S; S.init(NTOK, NQKV, G, bx);
        pg8::EpiQKV E{QKV, ssq1, a_q_norm, a_k_norm, b_q_norm, b_k_norm, {-1, 0.f, 0.f}};
        pg8::gemm_phase(lds, g, S, E, (unsigned*)(ctl + 32 + 2 * 3));
        if (BOTH(3)) GRID_BAR();
    }
    if (IN(4)) {
        STAMP(4);
        struct AUnit { att::KVSrc src; bf16_t* Qg; long rstride; float nslope2; int jlo_u, jhi_u, head; long tok0; int d; };
        auto decodeA = [&](int ua) -> AUnit {
            AUnit a; const int head = ua % 12, chunk = ua / 12, grp = head >> 2, dsh = 2 * grp, d = 1 << dsh;
            int sbase, T, c;
            if (chunk < 32) { sbase = 0; T = T_PROMPT; c = chunk; } else if (chunk < 64) { sbase = T_PROMPT; T = T_PROMPT; c = chunk - 32; }
            else if (chunk < 128) { sbase = 2 * T_PROMPT; T = T_SAMPLE; c = chunk - 64; } else { sbase = 2 * T_PROMPT + T_SAMPLE; T = T_SAMPLE; c = chunk - 128; }
            const int r = c & (d - 1), b = c >> dsh, nblk = (T >> dsh) / 256;
            a.jlo_u = (b == 0) ? 1 : 0; a.jhi_u = (b == nblk - 1) ? 4 : 5;
            a.rstride = (long)d * NQKV; a.head = head; a.d = d;
            bf16_t* base = QKV + (long)(sbase + r) * NQKV + head * 64;
            a.src.Kg = base + 768 + (long)(256 * b - 64) * a.rstride; a.src.Vg = base + 1536 + (long)(256 * b - 64) * a.rstride; a.src.rstride = a.rstride;
            a.src.row_lo = 64 * a.jlo_u; a.src.row_hi = 64 * a.jhi_u + 64;
            a.Qg = base + (long)(256 * b) * a.rstride; a.tok0 = (long)(sbase + r) + (long)(256 * b) * d;
            a.nslope2 = -fast_exp2(-8.0f * (float)(head + 1) / 12.0f) * LOG2E * (float)d;
            return a; };
        {
            constexpr int NA = (NTOK / 256) * 12;
            u32x4 kv[6], vv[6];
            if (bx < NA) { const AUnit f = decodeA(bx); att::load_kv<6>(f.src, kv, vv, tid); }
            for (int ua = bx; ua < NA; ua += G) {
                const AUnit cur = decodeA(ua);
                att::write_kv<6>(lds, cur.src, kv, vv, tid);
                __syncthreads();
                const int w = wave;
                bf16_t* Qg = cur.Qg + (long)(32 * w) * cur.rstride;
                bf16x8 qr[4]; att::load_q(Qg, cur.rstride, qr);
                if (ua + G < NA) { const AUnit nxt = decodeA(ua + G); att::load_kv<6>(nxt.src, kv, vv, tid); }
                {
                    const int jlo = (w >> 1) > cur.jlo_u ? (w >> 1) : cur.jlo_u; const int jhi = ((w >> 1) + 2) < cur.jhi_u ? ((w >> 1) + 2) : cur.jhi_u;
                    f32x16 o0, o1; float l;
                    att::attn_task<64>(lds, qr, jlo, jhi, (w >> 1) + 1, (w >> 1) + 1, 64 + 32 * w, cur.nslope2, o0, o1, l);
                    if (lane < 32) ltab[(size_t)(cur.tok0 + (long)(32 * w + lane) * cur.d) * 12 + cur.head] = l;
                    att::attn_store(lds, o0, o1, l, 0.f, Qg, cur.rstride, w);
                }
                __syncthreads();
            }
        }
        struct BUnit { att::KVSrc src; const bf16_t* Qg; bf16_t* Og; int jlo_u, jhi_u, kvh; };
        auto decodeB = [&](int ub) -> BUnit {
            BUnit u; const int kvh = ub & 1, t0 = (ub >> 1) * 64;
            int sbase, T;
            if (t0 < T_PROMPT) { sbase = 0; T = T_PROMPT; } else if (t0 < 2 * T_PROMPT) { sbase = T_PROMPT; T = T_PROMPT; }
            else if (t0 < 2 * T_PROMPT + T_SAMPLE) { sbase = 2 * T_PROMPT; T = T_SAMPLE; } else { sbase = 2 * T_PROMPT + T_SAMPLE; T = T_SAMPLE; }
            const int b = (t0 - sbase) / 64, nb = T / 64;
            u.jlo_u = (2 - b) > 0 ? (2 - b) : 0; u.jhi_u = (nb + 1 - b) < 4 ? (nb + 1 - b) : 4; u.kvh = kvh;
            u.src.Kg = QKV + (long)(sbase + 64 * (b - 2)) * NQKV + 2816 + kvh * 64; u.src.Vg = u.src.Kg + 128; u.src.rstride = (long)NQKV;
            u.src.row_lo = 64 * u.jlo_u; u.src.row_hi = 64 * u.jhi_u + 64;
            u.Qg = QKV + (long)(sbase + 64 * b) * NQKV + 2304 + kvh * 256; u.Og = Y + (long)(sbase + 64 * b) * NY + 256 + kvh * 256;
            return u; };
        {
            constexpr int NB = (NTOK / 64) * 2;
            u32x4 kv[5], vv[5];
            if (bx < NB) { const BUnit f = decodeB(bx); att::load_kv<5>(f.src, kv, vv, tid); }
            for (int ub = bx; ub < NB; ub += G) {
                const BUnit cur = decodeB(ub);
                att::write_kv<5>(lds, cur.src, kv, vv, tid);
                __syncthreads();
                const int w = wave, hq = w >> 1, half = w & 1, h = cur.kvh * 4 + hq;
                const bf16_t* Qg = cur.Qg + (long)(32 * half) * NQKV + hq * 64;
                bf16x8 qr[4]; att::load_q(Qg, (long)NQKV, qr);
                if (ub + G < NB) { const BUnit nxt = decodeB(ub + G); att::load_kv<5>(nxt.src, kv, vv, tid); }
                {
                    const float slope = fast_exp2(-(float)(h + 1));
                    f32x16 o0, o1; float l;
                    att::attn_task<128>(lds, qr, cur.jlo_u, cur.jhi_u, 1, 3, 128 + 32 * half, -slope * LOG2E, o0, o1, l);
                    const float extra = fast_exp2(b_sink[h] * LOG2E);
                    att::attn_store(lds, o0, o1, l, extra, cur.Og + (long)(32 * half) * NY + hq * 64, (long)NY, w);
                }
                __syncthreads();
            }
        }
        if (BOTH(4)) GRID_BAR();
    }
    if (IN(5)) {
        STAMP(5);
        const int gt = vcu * (NWAVES * 64) + tid, NT = G * NWAVES * 64;
        for (int idx = gt; idx < NTOK * 32; idx += NT) {
            const int tok = idx >> 5, part = idx & 31, sl = part >> 3, dch = part & 7;
            const float l0 = ltab[(size_t)tok * 12 + sl], l1 = ltab[(size_t)tok * 12 + 4 + sl], l2 = ltab[(size_t)tok * 12 + 8 + sl];
            const float inv = fast_rcp(l0 + l1 + l2); const float a0 = l0 * inv, a1 = l1 * inv, a2 = l2 * inv;
            const bf16_t* p = QKV + (size_t)tok * NQKV + sl * 64 + dch * 8;
            const u32x4 x0 = *(const u32x4*)p, x1 = *(const u32x4*)(p + 256), x2 = *(const u32x4*)(p + 512);
            u32x4 o;
#pragma unroll
            for (int i = 0; i < 4; ++i) o[i] = cvtpk(a0 * bf_lo(x0[i]) + a1 * bf_lo(x1[i]) + a2 * bf_lo(x2[i]), a0 * bf_hi(x0[i]) + a1 * bf_hi(x1[i]) + a2 * bf_hi(x2[i]));
            *(u32x4*)(Y + (size_t)tok * NY + sl * 64 + dch * 8) = o;
        }
        if (BOTH(5)) GRID_BAR();
    }
    if (IN(6)) {
        STAMP(6);
        { pg8::Gemm g{Y, Wpa_t, NTOK, DM, 256, NY}; pg8::StaticOrder S; S.init(NTOK, DM, G, bx); pg8::EpiPlain E{PA, DM}; pg8::gemm_phase(lds, g, S, E); }
        { pg8::Gemm g{Y + 256, Wpb_t, NTOK, DM, 512, NY}; pg8::StaticOrder S; S.init(NTOK, DM, G, bx); pg8::EpiPlain E{PB, DM}; pg8::gemm_phase(lds, g, S, E); }
        if (BOTH(6)) GRID_BAR();
    }
    if (IN(7)) {
        STAMP(7);
        pg8::Gemm g{HB, Wgate_t, NTOK, 2 * DM, DM, DM}; pg8::StaticOrder S; S.init(NTOK, 2 * DM, G, bx);
        pg8::EpiGate E{MB, ssq1, b_gate, PA, PB, {-1, 0.f, 0.f}};
        pg8::gemm_phase(lds, g, S, E, (unsigned*)(ctl + 32 + 2 * 7));
        if (BOTH(7)) GRID_BAR();
    }
    if (IN(8)) {
        STAMP(8);
        pg8::Gemm g{MB, Wout_t, NTOK, DM, DM, DM}; pg8::StaticOrder S; S.init(NTOK, DM, G, bx);
        pg8::EpiRes<false> E{HB, nullptr, ssq2, 1.0f};
        pg8::gemm_phase(lds, g, S, E, (unsigned*)(ctl + 32 + 2 * 8));
        if (BOTH(8)) GRID_BAR();
    }
    if (IN(9)) {
        STAMP(9);
        pg8::Gemm g{HB, W2gu_t, NTOK, 2 * DFF, DM, DM}; pg8::StaticOrder S; S.init(NTOK, 2 * DFF, G, bx);
        pg8::EpiSwiGLU E{ACT, ssq2, {-1, 0.f, 0.f}, 0};
        pg8::gemm_phase(lds, g, S, E, (unsigned*)(ctl + 32 + 2 * 9));
        if (BOTH(9)) GRID_BAR();
    }
    if (IN(10)) {
        STAMP(10);
        pg8::Gemm g{ACT, W2d_t, NTOK, DM, DFF, DFF}; pg8::StaticOrder S; S.init(NTOK, DM, G, bx);
        pg8::EpiRes<false> E{HB, nullptr, ssq3, 0.5f};
        pg8::gemm_phase(lds, g, S, E, (unsigned*)(ctl + 32 + 2 * 10));
        if (BOTH(10)) GRID_BAR();
    }
    if (IN(11)) {
        STAMP(11);
        f32x4 gfin[4];
#pragma unroll
        for (int j = 0; j < 4; ++j) gfin[j] = ((const f32x4*)final_norm)[lane + 64 * j];
        for (int m0 = gw * 4; m0 < NTOK; m0 += NGW * 4) {
            u32x2 v[4][4]; float sq[4];
            { const f32x4 t = ((const f32x4*)(ssq3 + (size_t)m0 * 16))[lane & 15];
              float a = (t[0] + t[1]) + (t[2] + t[3]); a += __shfl_xor(a, 1); a += __shfl_xor(a, 2);
#pragma unroll
              for (int q = 0; q < 4; ++q) sq[q] = __shfl(a, 4 * q); }
#pragma unroll
            for (int q = 0; q < 4; ++q)
#pragma unroll
                for (int j = 0; j < 4; ++j) v[q][j] = ((const u32x2*)(HB + (size_t)(m0 + q) * DM))[lane + 64 * j];
#pragma unroll
            for (int q = 0; q < 4; ++q) { const float rr = fast_rsq(sq[q] * (1.0f / DM) + NORM_EPS);
#pragma unroll
                for (int j = 0; j < 4; ++j) { f32x4 h; h[0] = bf_lo(v[q][j].x); h[1] = bf_hi(v[q][j].x); h[2] = bf_lo(v[q][j].y); h[3] = bf_hi(v[q][j].y);
                    ((f32x4*)(out + (size_t)(m0 + q) * DM))[lane + 64 * j] = h * rr * gfin[j]; } }
        }
#if PROBE_ON
        GRID_BAR();
        STAMP(12);
        GRID_BAR();
        float probe_scale = 1.0f, probe_x = 0.f;
        if (PROBE_A >= 100) { probe_scale = 1.025f + (float)__hip_atomic_load(ctl + 32 + (PROBE_A >= 100 ? PROBE_A - 100 : 0), RLX_AGENT) * 0.01f * (1.0f / 20000.0f); }
        else if (PROBE_A >= 0) { const unsigned t0 = __hip_atomic_load(ctl + 16 + (PROBE_A >= 0 ? PROBE_A : 0), RLX_AGENT), t1 = __hip_atomic_load(ctl + 17 + (PROBE_A >= 0 ? PROBE_A : 0), RLX_AGENT); probe_scale = 1.025f + (float)(t1 - t0) * 0.01f * (1.0f / 20000.0f); }
        if (PROBE_B >= 100) { probe_x = 20.0f + (float)__hip_atomic_load(ctl + 32 + (PROBE_B >= 100 ? PROBE_B - 100 : 0), RLX_AGENT) * 0.01f * 0.05f; }
        else if (PROBE_B >= 0) { const unsigned t0 = __hip_atomic_load(ctl + 16 + (PROBE_B >= 0 ? PROBE_B : 0), RLX_AGENT), t1 = __hip_atomic_load(ctl + 17 + (PROBE_B >= 0 ? PROBE_B : 0), RLX_AGENT); probe_x = 20.0f + (float)(t1 - t0) * 0.01f * 0.05f; }
        for (int m = NTOK_PROMPT + gw; m < NTOK; m += NGW) { f32x4* xr = (f32x4*)(out + (size_t)m * DM) + lane;
#pragma unroll
            for (int j = 0; j < 4; ++j) xr[64 * j] = xr[64 * j] * probe_scale; }
        if (PROBE_B >= 0 && bx == 0 && tid == 0) out[0] = probe_x;
#endif
    }
#undef IN
#undef BOTH
}

extern "C" void kernel_launch(void* const* d_in, const int* in_sizes, int n_in, void* d_out, int out_size, void* d_ws, size_t ws_size, hipStream_t stream) {
    static int grid = 0;
    if (grid == 0) {
        if (n_in != 23 || out_size != NTOK * DM || ws_size < WS_END) { fprintf(stderr, "kernel_launch: unexpected problem (n_in %d, out %d, ws %zu); nothing launched\n", n_in, out_size, ws_size); grid = -1; return; }
        int dev = 0, cus = 0, per_cu = 0;
        if (hipGetDevice(&dev) != hipSuccess || hipDeviceGetAttribute(&cus, hipDeviceAttributeMultiprocessorCount, dev) != hipSuccess) { fprintf(stderr, "kernel_launch: device query failed\n"); grid = -1; return; }
        if (hipFuncSetAttribute((const void*)enc_fwd, hipFuncAttributeMaxDynamicSharedMemorySize, LDS_BYTES) != hipSuccess) { fprintf(stderr, "kernel_launch: hipFuncSetAttribute failed\n"); grid = -1; return; }
        if (hipOccupancyMaxActiveBlocksPerMultiprocessor(&per_cu, (const void*)enc_fwd, NWAVES * 64, LDS_BYTES) != hipSuccess || per_cu < 1)
            fprintf(stderr, "kernel_launch: note: occupancy query reports %d workgroups per CU\n", per_cu);
        (void)hipGetLastError();
        grid = cus;
    }
    if (grid < 0) return;
    if (hipMemsetAsync((char*)d_ws + WS_CTL, 0, CTL_ZERO_BYTES, stream) != hipSuccess) { fprintf(stderr, "kernel_launch: memset failed\n"); return; }
    Args a{};
    for (int i = 0; i < 23; ++i) a.in[i] = (const float*)d_in[i];
    a.out = (float*)d_out; a.ws = (unsigned char*)d_ws;
#if MK_ONE_LAUNCH
    a.ph_lo = 0; a.ph_hi = NPHASE;
    hipLaunchKernelGGL(enc_fwd, dim3(grid), dim3(NWAVES * 64), LDS_BYTES, stream, a);
#else
    for (int p = 0; p < NPHASE; ++p) { a.ph_lo = p; a.ph_hi = p + 1; hipLaunchKernelGGL(enc_fwd, dim3(grid), dim3(NWAVES * 64), LDS_BYTES, stream, a); }
#endif
    const hipError_t le = hipPeekAtLastError();
    if (le != hipSuccess) fprintf(stderr, "kernel_launch: launch failed: %s\n", hipGetErrorName(le));
}
```

```cpp
#include <hip/hip_runtime.h>
#include <cstdio>
#include <cstdint>

#ifndef MK_ONE_LAUNCH
#define MK_ONE_LAUNCH 1
#endif
#define PROBE_A -1
#define PROBE_B -1
#define PROBE_ON (PROBE_A >= 0 || PROBE_B >= 0)

#define GAS __attribute__((address_space(1)))
#define LAS __attribute__((address_space(3)))
typedef unsigned short bf16_t;
typedef short bf16x8 __attribute__((ext_vector_type(8)));
typedef short s16x4 __attribute__((ext_vector_type(4)));
typedef float f32x4 __attribute__((ext_vector_type(4)));
typedef float f32x16 __attribute__((ext_vector_type(16)));
typedef unsigned u32x4 __attribute__((ext_vector_type(4)));
typedef unsigned u32x2 __attribute__((ext_vector_type(2)));
typedef float f32x2_t __attribute__((ext_vector_type(2)));
typedef __bf16 bf16x2_t __attribute__((ext_vector_type(2)));

constexpr int DM = 1024, DFF = 2816, NTOK = 49152, NQKV = 3072, NY = 768;
constexpr int T_PROMPT = 8192, T_SAMPLE = 16384, NTOK_PROMPT = 16384;
constexpr float NORM_EPS = 1e-6f;
constexpr float LOG2E = 1.4426950408889634f;
constexpr float QSCALE = 0.125f * LOG2E;

__device__ __forceinline__ unsigned cvtpk(float lo, float hi) { f32x2_t v = {lo, hi}; bf16x2_t b = __builtin_convertvector(v, bf16x2_t); return __builtin_bit_cast(unsigned, b); }
__device__ __forceinline__ float bf_lo(unsigned u) { return __builtin_bit_cast(float, u << 16); }
__device__ __forceinline__ float bf_hi(unsigned u) { return __builtin_bit_cast(float, u & 0xffff0000u); }
__device__ __forceinline__ float fast_exp2(float x) { return __builtin_amdgcn_exp2f(x); }
__device__ __forceinline__ float fast_rcp(float x) { return __builtin_amdgcn_rcpf(x); }
__device__ __forceinline__ float fast_rsq(float x) { return __builtin_amdgcn_rsqf(x); }
__device__ __forceinline__ float sigmoidf_(float a) { return fast_rcp(1.0f + fast_exp2(-LOG2E * a)); }

namespace pg8 {
constexpr int BM = 256, BK = 64, HALF = 128, HTB = HALF * BK * 2, STAGE_BYTES = 8 * HTB, NXCD = 8, WGM = 8;
__host__ __device__ __forceinline__ int lds_byte(int r, int c) { const int st = (r >> 4) * 2 + (c >> 5), rr = r & 15, cc = c & 31, ob = rr * 64 + cc * 2; return st * 1024 + (ob ^ (((ob >> 9) & 1) << 5)); }
__host__ __device__ __forceinline__ void stage_rc(int b, int& R, int& C) { const int st = b / 1024, sb = b % 1024, swz = sb ^ (((sb >> 9) & 1) << 5); R = (st >> 1) * 16 + swz / 64; C = (st & 1) * 32 + (swz % 64) / 2; }

struct Unit { int pm, pn; };
struct Gemm { const bf16_t* A; const bf16_t* Bt; int M, N, K, lda; };

struct StaticOrder {
    int nM, nN, nwg, G, c;
    __device__ void init(int M, int N, int G_, int c_) { nM = M / BM; nN = N / BM; nwg = nM * nN; G = G_; c = c_; }
    __device__ bool next(int i, Unit& u) const {
        const long L = (long)i * G + c; if (L >= nwg) return false;
        int wgid = (int)L; { const int q = nwg / NXCD, r = nwg % NXCD, xcd = wgid % NXCD, off = wgid / NXCD; wgid = (xcd < r ? xcd * (q + 1) : r * (q + 1) + (xcd - r) * q) + off; }
        const int nig = WGM * nN, gid = wgid / nig, fm = gid * WGM, gsz = (nM - fm) < WGM ? (nM - fm) : WGM;
        u.pm = fm + ((wgid % nig) % gsz); u.pn = (wgid % nig) / gsz; return true;
    }
};

template <class Epi>
__device__ __forceinline__ void gemm_phase(LAS unsigned char* lds, const Gemm g, const StaticOrder& S, const Epi& E, unsigned* probe_slot = nullptr) {
#if PROBE_ON
    unsigned pr_k = 0, pr_e = 0, pr_t = (unsigned)__builtin_amdgcn_s_memrealtime();
#endif
    const int tid = threadIdx.x, wid = __builtin_amdgcn_readfirstlane(tid >> 6), lane = tid & 63, wr = wid >> 2, wc = wid & 3, fr = lane & 15, fq = lane >> 4;
    const int K = g.K, nt = K / BK, lda = g.lda;
    unsigned voffA[2], voffB[2];
#pragma unroll
    for (int i = 0; i < 2; ++i) { int R, C; stage_rc(tid * 16 + i * 8192, R, C); voffA[i] = (unsigned)(R * lda + C) * 2u; voffB[i] = (unsigned)(R * K + C) * 2u; }
    const size_t kstep = (size_t)(BK * 2);
    const size_t hstepA = (size_t)HALF * lda * 2, hstepB = (size_t)HALF * K * 2;
    const size_t tstepA = 2 * hstepA, tstepB = 2 * hstepB;
    const unsigned ldsw = (unsigned)wid * 1024u;
    const int aoff = lds_byte(wr * 64 + fr, fq * 8), boff = lds_byte(wc * 32 + fr, fq * 8);
#define PG8_SA(b, h) (((b) * 2 + (h)) * HTB)
#define PG8_SB(b, h) ((4 + (b) * 2 + (h)) * HTB)
#define PG8_STAGE(bufoff, gbase, voff) do { _Pragma("unroll") for (int _i = 0; _i < 2; ++_i) \
        __builtin_amdgcn_global_load_lds((const unsigned*)((const char*)(gbase) + (voff)[_i]), (LAS unsigned*)(lds + (bufoff) + ldsw + _i * 8192), 16, 0, 0); } while (0)
#define PG8_LDA(dst, b, h) do { _Pragma("unroll") for (int m = 0; m < 4; ++m) _Pragma("unroll") for (int k = 0; k < 2; ++k) dst[m][k] = *(const LAS bf16x8*)(lds + PG8_SA(b, h) + aoff + m * 2048 + k * 1024); } while (0)
#define PG8_LDB(dst, b, h) do { _Pragma("unroll") for (int n = 0; n < 2; ++n) _Pragma("unroll") for (int k = 0; k < 2; ++k) dst[n][k] = *(const LAS bf16x8*)(lds + PG8_SB(b, h) + boff + n * 2048 + k * 1024); } while (0)
#define PG8_MMA(ai, bj, At, Bt) do { __builtin_amdgcn_s_setprio(1); _Pragma("unroll") for (int m = 0; m < 4; ++m) _Pragma("unroll") for (int n = 0; n < 2; ++n) _Pragma("unroll") for (int k = 0; k < 2; ++k) \
        acc[ai][bj][m][n] = __builtin_amdgcn_mfma_f32_16x16x32_bf16(Bt[n][k], At[m][k], acc[ai][bj][m][n], 0, 0, 0); __builtin_amdgcn_s_setprio(0); } while (0)
#define PG8_WAIT_V(n) asm volatile("s_waitcnt vmcnt(" #n ")" ::: "memory")
#define PG8_WAIT_L(n) asm volatile("s_waitcnt lgkmcnt(" #n ")" ::: "memory")
#define PG8_BAR __builtin_amdgcn_s_barrier()
#define PG8_SCHED __builtin_amdgcn_sched_barrier(0)
    Unit cur, nxt; int ui = 0;
    if (!S.next(0, cur)) return;
    f32x4 acc[2][2][4][2];
#pragma unroll
    for (int a = 0; a < 2; ++a)
#pragma unroll
        for (int b = 0; b < 2; ++b)
#pragma unroll
            for (int m = 0; m < 4; ++m)
#pragma unroll
                for (int n = 0; n < 2; ++n) acc[a][b][m][n] = (f32x4){0.f, 0.f, 0.f, 0.f};
    bf16x8 At[4][2], B0[2][2], B1[2][2];
    const char* cA = (const char*)g.A + (size_t)cur.pm * tstepA; const char* cB = (const char*)g.Bt + (size_t)cur.pn * tstepB;
    PG8_STAGE(PG8_SB(0, 0), cB, voffB); PG8_STAGE(PG8_SB(0, 1), cB + hstepB, voffB); PG8_STAGE(PG8_SA(0, 0), cA, voffA); PG8_STAGE(PG8_SA(0, 1), cA + hstepA, voffA);
    if (wr == 1) PG8_BAR;
    PG8_WAIT_V(2); PG8_BAR;
    PG8_STAGE(PG8_SB(1, 0), cB + kstep, voffB); PG8_STAGE(PG8_SA(1, 0), cA + kstep, voffA); PG8_STAGE(PG8_SB(1, 1), cB + hstepB + kstep, voffB);
    PG8_WAIT_V(6); PG8_BAR;
    for (;;) {
        const bool has_next = S.next(ui + 1, nxt);
        const char* nA = has_next ? (const char*)g.A + (size_t)nxt.pm * tstepA : cA; const char* nB = has_next ? (const char*)g.Bt + (size_t)nxt.pn * tstepB : cB;
        for (int t = 0; t < nt; t += 2) {
            const bool last = (t == nt - 2);
            const char* a1 = cA + (size_t)(t + 1) * kstep;
            const char* a2 = last ? nA : cA + (size_t)(t + 2) * kstep; const char* b2 = last ? nB : cB + (size_t)(t + 2) * kstep;
            const char* a3 = a2 + kstep; const char* b3 = b2 + kstep;
            PG8_LDB(B0, 0, 0); PG8_LDB(B1, 0, 1); PG8_SCHED; PG8_LDA(At, 0, 0); PG8_STAGE(PG8_SA(1, 1), a1 + hstepA, voffA);
            PG8_WAIT_V(8); PG8_WAIT_L(0); PG8_BAR; PG8_MMA(0, 0, At, B0); PG8_MMA(0, 1, At, B1); PG8_BAR; PG8_SCHED;
            PG8_LDA(At, 0, 1); PG8_STAGE(PG8_SB(0, 0), b2, voffB); PG8_STAGE(PG8_SB(0, 1), b2 + hstepB, voffB); PG8_STAGE(PG8_SA(0, 0), a2, voffA);
            PG8_WAIT_V(8); PG8_WAIT_L(0); PG8_BAR; PG8_MMA(1, 0, At, B0); PG8_MMA(1, 1, At, B1); PG8_BAR; PG8_SCHED;
            PG8_LDB(B0, 1, 0); PG8_LDB(B1, 1, 1); PG8_SCHED; PG8_LDA(At, 1, 0); PG8_STAGE(PG8_SA(0, 1), a2 + hstepA, voffA);
            PG8_WAIT_V(8); PG8_WAIT_L(0); PG8_BAR; PG8_MMA(0, 0, At, B0); PG8_MMA(0, 1, At, B1); PG8_BAR; PG8_SCHED;
            PG8_LDA(At, 1, 1); PG8_STAGE(PG8_SB(1, 0), b3, voffB); PG8_STAGE(PG8_SB(1, 1), b3 + hstepB, voffB); PG8_STAGE(PG8_SA(1, 0), a3, voffA);
            PG8_WAIT_V(8); PG8_WAIT_L(0); PG8_BAR; PG8_MMA(1, 0, At, B0); PG8_MMA(1, 1, At, B1); PG8_BAR; PG8_SCHED;
        }
        if (wr == 0) PG8_BAR;
#if PROBE_ON
        { const unsigned t = (unsigned)__builtin_amdgcn_s_memrealtime(); pr_k += t - pr_t; pr_t = t; }
#endif
        E(acc, cur, wr, wc, fr, fq, lane);
#if PROBE_ON
        { const unsigned t = (unsigned)__builtin_amdgcn_s_memrealtime(); pr_e += t - pr_t; pr_t = t; }
#endif
        if (!has_next) break;
#pragma unroll
        for (int a = 0; a < 2; ++a)
#pragma unroll
            for (int b = 0; b < 2; ++b)
#pragma unroll
                for (int m = 0; m < 4; ++m)
#pragma unroll
                    for (int n = 0; n < 2; ++n) acc[a][b][m][n] = (f32x4){0.f, 0.f, 0.f, 0.f};
        cur = nxt; cA = nA; cB = nB; ++ui;
        if (wr == 1) PG8_BAR;
    }
    PG8_WAIT_V(0);
    PG8_BAR;
#if PROBE_ON
    if (probe_slot && blockIdx.x == 0 && threadIdx.x == 0) { __hip_atomic_store(probe_slot, pr_k, __ATOMIC_RELAXED, __HIP_MEMORY_SCOPE_AGENT); __hip_atomic_store(probe_slot + 1, pr_e, __ATOMIC_RELAXED, __HIP_MEMORY_SCOPE_AGENT); }
#endif
#undef PG8_SA
#undef PG8_SB
#undef PG8_STAGE
#undef PG8_LDA
#undef PG8_LDB
#undef PG8_MMA
#undef PG8_WAIT_V
#undef PG8_WAIT_L
#undef PG8_BAR
#undef PG8_SCHED
}

struct RowRsCache { int pm; float r0, r1; };
__device__ __forceinline__ void row_rs(const float* ssq, int pm, int wr, int lane, float& r0, float& r1) {
    const f32x4* p0 = (const f32x4*)(ssq + (size_t)(pm * BM + wr * 64 + lane) * 16); const f32x4* p1 = p0 + HALF * 4;
    const f32x4 a0 = p0[0], a1 = p0[1], a2 = p0[2], a3 = p0[3], b0 = p1[0], b1 = p1[1], b2 = p1[2], b3 = p1[3];
    const f32x4 sa = (a0 + a1) + (a2 + a3), sb = (b0 + b1) + (b2 + b3);
    r0 = fast_rsq(((sa[0] + sa[1]) + (sa[2] + sa[3])) * (1.0f / DM) + NORM_EPS);
    r1 = fast_rsq(((sb[0] + sb[1]) + (sb[2] + sb[3])) * (1.0f / DM) + NORM_EPS);
}

struct EpiSwiGLU {
    bf16_t* O; const float* ssq; mutable RowRsCache rc; int pn_off;
    __device__ __forceinline__ void operator()(const f32x4 (&acc)[2][2][4][2], const Unit& u, int wr, int wc, int fr, int fq, int lane) const {
        if (u.pm != rc.pm) { row_rs(ssq, u.pm, wr, lane, rc.r0, rc.r1); rc.pm = u.pm; }
        const float r0 = rc.r0, r1 = rc.r1;
        const int col0 = (u.pn + pn_off) * 128 + wc * 32 + fq * 8;
#pragma unroll
        for (int ai = 0; ai < 2; ++ai)
#pragma unroll
            for (int m = 0; m < 4; ++m) {
                const float rr = __shfl(ai ? r1 : r0, 16 * m + fr);
                const size_t row = (size_t)(u.pm * BM + ai * HALF + wr * 64 + m * 16 + fr);
                float o[8];
#pragma unroll
                for (int bj = 0; bj < 2; ++bj)
#pragma unroll
                    for (int e = 0; e < 4; ++e) { const float gt = acc[ai][bj][m][0][e] * rr, up = acc[ai][bj][m][1][e] * rr;
                        o[bj * 4 + e] = gt * up * fast_rcp(1.0f + fast_exp2(-LOG2E * gt)); }
                u32x4 w; w.x = cvtpk(o[0], o[1]); w.y = cvtpk(o[2], o[3]); w.z = cvtpk(o[4], o[5]); w.w = cvtpk(o[6], o[7]);
                *(u32x4*)(O + row * DFF + col0) = w;
            }
    }
};

template <bool F32OUT> struct EpiRes {
    bf16_t* hb; float* out; float* ssq; float scale;
    __device__ __forceinline__ void operator()(const f32x4 (&acc)[2][2][4][2], const Unit& u, int wr, int wc, int fr, int fq, int lane) const {
        const int col0 = u.pn * BM + wc * 64 + 16 * fq;
        const size_t rowb = (size_t)(u.pm * BM + wr * 64 + fr);
#pragma unroll
        for (int ai = 0; ai < 2; ++ai) {
            u32x4 rs[2][4][2];
#pragma unroll
            for (int m = 0; m < 4; ++m)
#pragma unroll
                for (int bj = 0; bj < 2; ++bj) rs[ai][m][bj] = *(const u32x4*)(hb + (rowb + ai * HALF + m * 16) * DM + col0 + bj * 8);
#pragma unroll
            for (int m = 0; m < 4; ++m) {
                const size_t row = rowb + ai * HALF + m * 16; const size_t off = row * DM + col0;
                float ss = 0.f;
#pragma unroll
                for (int bj = 0; bj < 2; ++bj) { const u32x4 r = rs[ai][m][bj]; const f32x4 a0 = acc[ai][bj][m][0] * scale, a1 = acc[ai][bj][m][1] * scale;
                    f32x4 v0, v1; v0[0] = bf_lo(r[0]) + a0[0]; v0[1] = bf_hi(r[0]) + a0[1]; v0[2] = bf_lo(r[1]) + a0[2]; v0[3] = bf_hi(r[1]) + a0[3];
                    v1[0] = bf_lo(r[2]) + a1[0]; v1[1] = bf_hi(r[2]) + a1[1]; v1[2] = bf_lo(r[3]) + a1[2]; v1[3] = bf_hi(r[3]) + a1[3];
                    ss += ((v0[0] * v0[0] + v0[1] * v0[1]) + (v0[2] * v0[2] + v0[3] * v0[3])) + ((v1[0] * v1[0] + v1[1] * v1[1]) + (v1[2] * v1[2] + v1[3] * v1[3]));
                    if (F32OUT) { *(f32x4*)(out + off + bj * 8) = v0; *(f32x4*)(out + off + bj * 8 + 4) = v1; }
                    else { u32x4 w; w.x = cvtpk(v0[0], v0[1]); w.y = cvtpk(v0[2], v0[3]); w.z = cvtpk(v1[0], v1[1]); w.w = cvtpk(v1[2], v1[3]); *(u32x4*)(hb + off + bj * 8) = w; } }
                ss += __shfl_xor(ss, 16); ss += __shfl_xor(ss, 32);
                if (fq == 0) ssq[row * 16 + u.pn * 4 + wc] = ss;
            }
            asm volatile("" ::: "memory");
        }
    }
};

struct EpiQKV {
    bf16_t* O; const float* ssq; const float *gaq, *gak, *gbq, *gbk; mutable RowRsCache rc;
    __device__ __forceinline__ void operator()(const f32x4 (&acc)[2][2][4][2], const Unit& u, int wr, int wc, int fr, int fq, int lane) const {
        if (u.pm != rc.pm) { row_rs(ssq, u.pm, wr, lane, rc.r0, rc.r1); rc.pm = u.pm; }
        const float r0 = rc.r0, r1 = rc.r1;
        const float* gp = nullptr; float qs = 1.0f;
        if (u.pn < 3) { gp = gaq; qs = QSCALE; } else if (u.pn < 6) { gp = gak; } else if (u.pn < 9) { gp = nullptr; } else if (u.pn < 11) { gp = gbq; qs = QSCALE; } else if (wc < 2) { gp = gbk; }
        float gn[16];
#pragma unroll
        for (int i = 0; i < 16; ++i) gn[i] = 1.0f;
        if (gp) {
#pragma unroll
            for (int i = 0; i < 4; ++i) { const f32x4 t = *(const f32x4*)(gp + 16 * fq + 4 * i); gn[4 * i] = t[0] * qs; gn[4 * i + 1] = t[1] * qs; gn[4 * i + 2] = t[2] * qs; gn[4 * i + 3] = t[3] * qs; }
        }
        const int col0 = u.pn * BM + wc * 64 + fq * 16;
#pragma unroll
        for (int ai = 0; ai < 2; ++ai)
#pragma unroll
            for (int m = 0; m < 4; ++m) {
                const float rr = __shfl(ai ? r1 : r0, 16 * m + fr);
                const size_t row = (size_t)(u.pm * BM + ai * HALF + wr * 64 + m * 16 + fr);
                float v[16]; float ss = 0.f;
#pragma unroll
                for (int bj = 0; bj < 2; ++bj)
#pragma unroll
                    for (int n = 0; n < 2; ++n)
#pragma unroll
                        for (int e = 0; e < 4; ++e) { const float x = acc[ai][bj][m][n][e] * rr; v[bj * 8 + n * 4 + e] = x; ss += x * x; }
                ss += __shfl_xor(ss, 16); ss += __shfl_xor(ss, 32);
                const float hr = gp ? fast_rsq(ss * (1.0f / 64.0f) + NORM_EPS) : 1.0f;
#pragma unroll
                for (int i = 0; i < 16; ++i) v[i] = v[i] * hr * gn[i];
                u32x4 w0, w1; w0.x = cvtpk(v[0], v[1]); w0.y = cvtpk(v[2], v[3]); w0.z = cvtpk(v[4], v[5]); w0.w = cvtpk(v[6], v[7]);
                w1.x = cvtpk(v[8], v[9]); w1.y = cvtpk(v[10], v[11]); w1.z = cvtpk(v[12], v[13]); w1.w = cvtpk(v[14], v[15]);
                bf16_t* p = O + row * NQKV + col0; *(u32x4*)p = w0; *(u32x4*)(p + 8) = w1;
            }
    }
};

struct EpiPlain {
    bf16_t* O; int ldc;
    __device__ __forceinline__ void operator()(const f32x4 (&acc)[2][2][4][2], const Unit& u, int wr, int wc, int fr, int fq, int lane) const {
        const int col0 = u.pn * BM + wc * 32 + fq * 8;
#pragma unroll
        for (int ai = 0; ai < 2; ++ai)
#pragma unroll
            for (int m = 0; m < 4; ++m) {
                const size_t row = (size_t)(u.pm * BM + ai * HALF + wr * 64 + m * 16 + fr);
#pragma unroll
                for (int bj = 0; bj < 2; ++bj) { const f32x4 v0 = acc[ai][bj][m][0], v1 = acc[ai][bj][m][1];
                    u32x4 w; w.x = cvtpk(v0[0], v0[1]); w.y = cvtpk(v0[2], v0[3]); w.z = cvtpk(v1[0], v1[1]); w.w = cvtpk(v1[2], v1[3]);
                    *(u32x4*)(O + row * ldc + col0 + bj * HALF) = w; }
            }
    }
};

struct EpiGate {
    bf16_t* O; const float* ssq; const float* bgate; const bf16_t* PA; const bf16_t* PB; mutable RowRsCache rc;
    __device__ __forceinline__ void operator()(const f32x4 (&acc)[2][2][4][2], const Unit& u, int wr, int wc, int fr, int fq, int lane) const {
        if (u.pm != rc.pm) { row_rs(ssq, u.pm, wr, lane, rc.r0, rc.r1); rc.pm = u.pm; }
        const float r0 = rc.r0, r1 = rc.r1;
        const int col0 = u.pn * 128 + wc * 32 + fq * 8;
        float ba[8], bb[8];
        { const f32x4 t0 = *(const f32x4*)(bgate + col0), t1 = *(const f32x4*)(bgate + col0 + 4), t2 = *(const f32x4*)(bgate + DM + col0), t3 = *(const f32x4*)(bgate + DM + col0 + 4);
#pragma unroll
          for (int e = 0; e < 4; ++e) { ba[e] = t0[e]; ba[4 + e] = t1[e]; bb[e] = t2[e]; bb[4 + e] = t3[e]; } }
#pragma unroll
        for (int ai = 0; ai < 2; ++ai) {
            u32x4 pas[2][4], pbs[2][4];
#pragma unroll
            for (int m = 0; m < 4; ++m) { const size_t row = (size_t)(u.pm * BM + ai * HALF + wr * 64 + m * 16 + fr);
                pas[ai][m] = *(const u32x4*)(PA + row * DM + col0); pbs[ai][m] = *(const u32x4*)(PB + row * DM + col0); }
#pragma unroll
            for (int m = 0; m < 4; ++m) {
                const float rr = __shfl(ai ? r1 : r0, 16 * m + fr);
                const size_t row = (size_t)(u.pm * BM + ai * HALF + wr * 64 + m * 16 + fr);
                const u32x4 pa = pas[ai][m], pb = pbs[ai][m];
                float o[8];
#pragma unroll
                for (int bj = 0; bj < 2; ++bj)
#pragma unroll
                    for (int e = 0; e < 4; ++e) { const int i = bj * 4 + e;
                        const float ga = sigmoidf_(acc[ai][bj][m][0][e] * rr + ba[i]), gb = sigmoidf_(acc[ai][bj][m][1][e] * rr + bb[i]);
                        const unsigned wa = pa[i >> 1], wb = pb[i >> 1];
                        const float xa = (i & 1) ? bf_hi(wa) : bf_lo(wa), xb = (i & 1) ? bf_hi(wb) : bf_lo(wb);
                        o[i] = ga * xa + gb * xb; }
                u32x4 w; w.x = cvtpk(o[0], o[1]); w.y = cvtpk(o[2], o[3]); w.z = cvtpk(o[4], o[5]); w.w = cvtpk(o[6], o[7]);
                *(u32x4*)(O + row * DM + col0) = w;
            }
            asm volatile("" ::: "memory");
        }
    }
};
}

namespace att {
constexpr int KPL = 6144 + 16, VPL = 24576 + 64;
constexpr int OFF_K = 0, OFF_V = 8 * KPL, OFF_WS = OFF_V + 2 * VPL, OFF_OST = OFF_WS + 8 * 256, LDS_BYTES = OFF_OST + 8 * 4096;
__device__ __forceinline__ int crow(int r, int hi) { return (r & 3) + 8 * (r >> 2) + 4 * hi; }
__device__ __forceinline__ s16x4 vtr(const LAS unsigned char* p) { return __builtin_bit_cast(s16x4, __builtin_amdgcn_ds_read_tr16_b64_v4i16((LAS s16x4*)p)); }

struct KVSrc { const bf16_t* Kg; const bf16_t* Vg; long rstride; int row_lo, row_hi; };
template <int NIT>
__device__ __forceinline__ void load_kv(const KVSrc& src, u32x4 (&kv)[NIT], u32x4 (&vv)[NIT], int tid) {
#pragma unroll
    for (int it = 0; it < NIT; ++it) { const int q = tid + it * 512, row = q >> 3, c = q & 7;
        if (row >= src.row_lo && row < src.row_hi) { kv[it] = *(const u32x4*)(src.Kg + (long)row * src.rstride + c * 8); vv[it] = *(const u32x4*)(src.Vg + (long)row * src.rstride + c * 8); } }
}
template <int NIT>
__device__ __forceinline__ void write_kv(LAS unsigned char* lds, const KVSrc& src, const u32x4 (&kv)[NIT], const u32x4 (&vv)[NIT], int tid) {
#pragma unroll
    for (int it = 0; it < NIT; ++it) { const int q = tid + it * 512, row = q >> 3, c = q & 7;
        if (row >= src.row_lo && row < src.row_hi) { *(LAS u32x4*)(lds + OFF_K + c * KPL + row * 16) = kv[it]; *(LAS u32x4*)(lds + OFF_V + (c >> 2) * VPL + row * 64 + (c & 3) * 16) = vv[it]; } }
}
__device__ __forceinline__ void load_q(const bf16_t* Qg, long qstride, bf16x8 (&qr)[4]) {
    const int lane = threadIdx.x & 63, r32 = lane & 31, hi = lane >> 5;
#pragma unroll
    for (int d0 = 0; d0 < 4; ++d0) qr[d0] = *(const bf16x8*)(Qg + (long)r32 * qstride + d0 * 16 + hi * 8);
}

template <int HW>
__device__ __forceinline__ void attn_half(const LAS unsigned char* kt, const LAS unsigned char* vt, const bf16x8 (&qr)[4], float basef, float nslope2, f32x16& oa, f32x16& ob, float& l) {
    f32x16 p0 = {};
#pragma unroll
    for (int d0 = 0; d0 < 4; ++d0) { const bf16x8 b0 = *(const LAS bf16x8*)(kt + 2 * d0 * KPL);
        p0 = __builtin_amdgcn_mfma_f32_32x32x16_bf16(b0, qr[d0], p0, 0, 0, 0); }
    float s = 0.f;
#pragma unroll
    for (int r = 0; r < 16; ++r) { const float cc = (float)((r & 3) + 8 * (r >> 2));
        const float a0 = __builtin_fabsf(basef - cc);
        float v0 = __builtin_fmaf(a0, nslope2, p0[r]);
        v0 = (a0 <= (float)HW) ? v0 : -INFINITY;
        p0[r] = fast_exp2(v0); s += p0[r]; }
    l += s;
    u32x4 pw[2];
#pragma unroll
    for (int i = 0; i < 4; ++i) { pw[0][i] = cvtpk(p0[2 * i], p0[2 * i + 1]); pw[1][i] = cvtpk(p0[8 + 2 * i], p0[9 + 2 * i]); }
#pragma unroll
    for (int ks = 0; ks < 2; ++ks) {
        const s16x4 lo0 = vtr(vt + ks * 1024), hi0 = vtr(vt + ks * 1024 + 512), lo1 = vtr(vt + VPL + ks * 1024), hi1 = vtr(vt + VPL + ks * 1024 + 512);
        const bf16x8 pa = __builtin_bit_cast(bf16x8, pw[ks]);
        const bf16x8 v0 = (bf16x8){lo0[0], lo0[1], lo0[2], lo0[3], hi0[0], hi0[1], hi0[2], hi0[3]}, v1 = (bf16x8){lo1[0], lo1[1], lo1[2], lo1[3], hi1[0], hi1[1], hi1[2], hi1[3]};
        oa = __builtin_amdgcn_mfma_f32_32x32x16_bf16(pa, v0, oa, 0, 0, 0); ob = __builtin_amdgcn_mfma_f32_32x32x16_bf16(pa, v1, ob, 0, 0, 0);
    }
}

template <int HW>
__device__ __forceinline__ void attn_task(LAS unsigned char* lds, const bf16x8 (&qr)[4], int hlo, int hhi, int qoff, float nslope2, f32x16& o0, f32x16& o1, float& lsum) {
    const int lane = threadIdx.x & 63, r32 = lane & 31, hi = lane >> 5;
    const LAS unsigned char* kp = lds + OFF_K + hi * KPL + r32 * 16;
    const LAS unsigned char* vp = lds + OFF_V + ((lane >> 4) & 1) * 32 + (lane & 3) * 8 + (4 * hi + ((lane & 15) >> 2)) * 64;
    f32x16 oa = {}, ob = {}; float l = 0.f;
    for (int h = hlo; h <= hhi; ++h) {
        const float basef = (float)(qoff + r32 - 32 * h - 4 * hi);
        attn_half<HW>(kp + h * 512, vp + h * 2048, qr, basef, nslope2, oa, ob, l);
    }
    l += __shfl_xor(l, 32);
    o0 = oa; o1 = ob; lsum = l;
}

__device__ __forceinline__ void attn_store(LAS unsigned char* lds, const f32x16& o0, const f32x16& o1, float l, float extra, bf16_t* Og, long ostride, int wid) {
    const int lane = threadIdx.x & 63, r32 = lane & 31, hi = lane >> 5;
    LAS float* wsf = (LAS float*)(lds + OFF_WS + wid * 256);
    if (hi == 0) wsf[r32] = fast_rcp(l + extra);
    LAS bf16_t* stg = (LAS bf16_t*)(lds + OFF_OST + wid * 4096);
#pragma unroll
    for (int r = 0; r < 16; ++r) { const int orow = crow(r, hi); const float rl = wsf[orow];
        const unsigned a = cvtpk(o0[r] * rl, 0.f), b = cvtpk(o1[r] * rl, 0.f);
        stg[orow * 64 + r32] = (bf16_t)(a & 0xffffu); stg[orow * 64 + 32 + r32] = (bf16_t)(b & 0xffffu); }
#pragma unroll
    for (int i = 0; i < 4; ++i) { const int row = i * 8 + (lane >> 3), ch = lane & 7; const u32x4 v = *(const LAS u32x4*)(stg + row * 64 + ch * 8); *(u32x4*)(Og + (long)row * ostride + ch * 8) = v; }
}
}

constexpr int NWAVES = 8;
constexpr int NPHASE = 12;
constexpr size_t MiB = 1u << 20;
constexpr size_t WS_CTL = 0, CTL_ZERO_BYTES = 1 * MiB;
constexpr size_t WS_SSQ0 = 1 * MiB, WS_SSQ1 = 4 * MiB, WS_SSQ2 = 7 * MiB, WS_SSQ3 = 10 * MiB;
constexpr size_t WS_LTAB = 13 * MiB;
constexpr size_t WS_WIN = 16 * MiB, WS_WGATE = 22 * MiB, WS_WPA = 26 * MiB, WS_WPB = 27 * MiB, WS_WOUT = 28 * MiB, WS_W2GU = 30 * MiB, WS_W2D = 41 * MiB;
constexpr size_t WS_HB = 47 * MiB;
constexpr size_t WS_W1GU = 143 * MiB, WS_W1D = 154 * MiB;
constexpr size_t WS_Y = 143 * MiB;
constexpr size_t WS_ACT = 160 * MiB;
constexpr size_t WS_QKV = 215 * MiB;
constexpr size_t WS_PA = 215 * MiB, WS_PB = 311 * MiB, WS_M = 407 * MiB;
constexpr size_t WS_END = 503 * MiB;
constexpr int CW_BAR = 4096;

constexpr int RING_BYTES = 134144;
constexpr int LDSCTL_OFF = RING_BYTES, MISC_OFF = LDSCTL_OFF + 320;
constexpr int LDS_BYTES = 147456;
static_assert(att::LDS_BYTES <= RING_BYTES && pg8::STAGE_BYTES <= RING_BYTES && MISC_OFF + 128 <= LDS_BYTES, "LDS map");

typedef GAS unsigned gu32;
#define RLX_AGENT __ATOMIC_RELAXED, __HIP_MEMORY_SCOPE_AGENT
#define LDS_WAIT() asm volatile("s_waitcnt lgkmcnt(0)" ::: "memory")

#define XB_TMO      128
#define XB_XCNT(j)  (256  + 64 * (j))
#define XB_XSUB(j)  (1280 + 64 * (j))
#define XB_XGEN(j)  (2304 + 64 * (j))
#define XB_TOP      3328
#define XB_TOPGEN   3392
#define XCD_BAR_WORDS 3456
#define XB_SPIN_CAP (1u << 18)
__device__ __forceinline__ unsigned xb_ld(unsigned* p)              { return __hip_atomic_load(p, __ATOMIC_RELAXED, __HIP_MEMORY_SCOPE_AGENT); }
__device__ __forceinline__ unsigned xb_add(unsigned* p, unsigned v) { return __hip_atomic_fetch_add(p, v, __ATOMIC_RELAXED, __HIP_MEMORY_SCOPE_AGENT); }
__device__ __forceinline__ unsigned xb_xcc_id() { return (unsigned)__builtin_amdgcn_s_getreg((3 << 11) | 20) & 0xFu; }
#define XB_SPIN(cond, bar) do { unsigned _sp = 0; while (cond) { __builtin_amdgcn_s_sleep(1); \
    if ((++_sp & 255u) == 0u) { if (xb_ld(&(bar)[XB_TMO])) break; if (_sp > XB_SPIN_CAP) { atomicAdd(&(bar)[XB_TMO], 1u); break; } } } } while (0)
struct XcdBarrier { unsigned* bar; unsigned x; volatile LAS unsigned* st; };
__device__ __forceinline__ XcdBarrier xcd_barrier_post(unsigned* bar, volatile LAS unsigned* st) {
    XcdBarrier b; b.bar = bar; b.x = xb_xcc_id(); b.st = st;
    if (threadIdx.x == 0) (void)xb_add(&bar[XB_XCNT(b.x)], 1u);
    return b;
}
__device__ __forceinline__ void xcd_barrier_complete(unsigned* bar, unsigned x, unsigned& nloc, unsigned& nx) {
    const unsigned G = gridDim.x * gridDim.y * gridDim.z;
    unsigned sum, cnt, mine, sp = 0u;
    for (;;) {
        sum = 0u; cnt = 0u; mine = 0u;
#pragma unroll
        for (unsigned j = 0; j < 16; ++j) { const unsigned c = xb_ld(&bar[XB_XCNT(j)]); sum += c; cnt += (c > 0u) ? 1u : 0u; mine = (j == x) ? c : mine; }
        if (sum == G) break;
        __builtin_amdgcn_s_sleep(1);
        if ((++sp & 255u) == 0u) { if (xb_ld(&bar[XB_TMO])) break; if (sp > XB_SPIN_CAP) { atomicAdd(&bar[XB_TMO], 1u); break; } }
    }
    nloc = mine > 0u ? mine : 1u; nx = cnt > 0u ? cnt : 1u;
}
__device__ __forceinline__ void xcd_barrier(const XcdBarrier& b) {
    asm volatile("s_waitcnt vmcnt(0)" ::: "memory");
    __syncthreads();
    if (threadIdx.x == 0) {
        unsigned* bar = b.bar;
        __builtin_amdgcn_s_waitcnt(0);
        unsigned nloc = b.st[0], nx = b.st[1];
        if (nloc == 0u) { xcd_barrier_complete(bar, b.x, nloc, nx); b.st[0] = nloc; b.st[1] = nx; }
        const unsigned old = xb_add(&bar[XB_XSUB(b.x)], 1u);
        const unsigned gen = old / nloc;
        if (old + 1u == (gen + 1u) * nloc) {
            __builtin_amdgcn_fence(__ATOMIC_RELEASE, "agent");
            asm volatile("s_waitcnt vmcnt(0)" ::: "memory");
            const unsigned og = xb_add(&bar[XB_TOP], 1u);
            const unsigned tg = og / nx;
            if (og + 1u == (tg + 1u) * nx) xb_add(&bar[XB_TOPGEN], 1u);
            else XB_SPIN(xb_ld(&bar[XB_TOPGEN]) == tg, bar);
            __builtin_amdgcn_fence(__ATOMIC_ACQUIRE, "agent");
            xb_add(&bar[XB_XGEN(b.x)], 1u);
            asm volatile("s_waitcnt vmcnt(0)" ::: "memory");
        } else {
            XB_SPIN(xb_ld(&bar[XB_XGEN(b.x)]) == gen, bar);
            __builtin_amdgcn_fence(__ATOMIC_ACQUIRE, "agent");
            asm volatile("s_waitcnt vmcnt(0)" ::: "memory");
        }
    }
    __syncthreads();
}

__device__ __forceinline__ float wave_sum(float v) {
#pragma unroll
    for (int o = 1; o < 64; o <<= 1) v += __shfl_xor(v, o);
    return v;
}
__device__ __forceinline__ float wave_max(float v) {
#pragma unroll
    for (int o = 1; o < 64; o <<= 1) v = __builtin_fmaxf(v, __shfl_xor(v, o));
    return v;
}

__device__ __forceinline__ int map_gu(int sel, int col) { const int pn = col >> 7, c = col & 127, wc = c >> 5, fq = (c >> 3) & 3, bj = (c >> 2) & 1, e = c & 3; return 256 * pn + 128 * bj + 32 * wc + 16 * sel + 4 * fq + e; }
__device__ __forceinline__ int map_head(int col) { const int pn = col >> 8, c = col & 255, wc = c >> 6, ch = c & 63, fq = ch >> 4, bj = (ch >> 3) & 1, n = (ch >> 2) & 1, e = ch & 3; return 256 * pn + 128 * bj + 32 * wc + 16 * n + 4 * fq + e; }
__device__ __forceinline__ int map_p8(int col) { const int pn = col >> 8, c = col & 255, bj = c >> 7, wc = (c >> 5) & 3, fq = (c >> 3) & 3, n = (c >> 2) & 1, e = c & 3; return 256 * pn + 128 * bj + 32 * wc + 16 * n + 4 * fq + e; }
template <int MAPK, bool GAIN>
__device__ __forceinline__ void transpose_item(const float* W, int K, int N, bf16_t* WT, const float* gain, LAS float* scr, int item, int lane, int coloff = 0) {
    const int nblk = N / 32, kb = item / nblk, nb = item % nblk, k0 = 64 * kb, n0 = 32 * nb;
    const int c = lane & 7;
    f32x4 g0 = {1.f, 1.f, 1.f, 1.f}, g1 = {1.f, 1.f, 1.f, 1.f};
    if (GAIN) { g0 = *(const f32x4*)(gain + k0 + 8 * c); g1 = *(const f32x4*)(gain + k0 + 8 * c + 4); }
    float t[32];
#pragma unroll
    for (int i = 0; i < 32; ++i) t[i] = W[(size_t)(k0 + 2 * i + (lane >> 5)) * N + n0 + (lane & 31)];
#pragma unroll
    for (int i = 0; i < 32; ++i) scr[(2 * i + (lane >> 5)) * 33 + (lane & 31)] = t[i];
    LDS_WAIT(); asm volatile("" ::: "memory");
#pragma unroll
    for (int j = 0; j < 4; ++j) { const int n = (lane >> 3) + 8 * j; const LAS float* s = scr + (8 * c) * 33 + n;
        u32x4 o; o.x = cvtpk(s[0 * 33] * g0[0], s[1 * 33] * g0[1]); o.y = cvtpk(s[2 * 33] * g0[2], s[3 * 33] * g0[3]); o.z = cvtpk(s[4 * 33] * g1[0], s[5 * 33] * g1[1]); o.w = cvtpk(s[6 * 33] * g1[2], s[7 * 33] * g1[3]);
        const int col = n0 + n - coloff;
        const int row = MAPK == 0 ? col : MAPK == 1 ? map_gu(0, col) : MAPK == 2 ? map_gu(1, col) : MAPK == 3 ? map_head(col) : map_p8(col);
        *(u32x4*)(WT + (size_t)row * K + k0 + 8 * c) = o; }
    LDS_WAIT(); asm volatile("" ::: "memory");
}

struct Args { const float* in[23]; float* out; unsigned char* ws; int ph_lo, ph_hi; };

__global__ void __launch_bounds__(NWAVES * 64, 2) enc_fwd(Args args) {
    extern __shared__ __attribute__((aligned(16))) unsigned char lds_raw[];
    LAS unsigned char* lds = (LAS unsigned char*)lds_raw;
    volatile LAS unsigned* MISC = (volatile LAS unsigned*)(lds + MISC_OFF);
    const int tid = threadIdx.x, lane = tid & 63, wave = __builtin_amdgcn_readfirstlane(tid >> 6);
    const int G = gridDim.x, bx = blockIdx.x;
    const int vcu = (G % 8 == 0) ? (bx % 8) * (G / 8) + bx / 8 : bx;
    unsigned char* ws = args.ws;
    gu32* ctl = (gu32*)(ws + WS_CTL);
    const float* x_prompt = args.in[0]; const float* x_sample = args.in[1];
    const float* ffn1_norm = args.in[2]; const float* ffn1_wg = args.in[3]; const float* ffn1_wu = args.in[4]; const float* ffn1_wd = args.in[5];
    const float* mix_norm = args.in[6]; const float* w_in = args.in[7];
    const float* a_q_norm = args.in[8]; const float* a_k_norm = args.in[9]; const float* b_q_norm = args.in[10]; const float* b_k_norm = args.in[11]; const float* b_sink = args.in[12];
    const float* w_proj_a = args.in[13]; const float* w_proj_b = args.in[14]; const float* w_gate = args.in[15]; const float* b_gate = args.in[16]; const float* w_out = args.in[17];
    const float* ffn2_norm = args.in[18]; const float* ffn2_wg = args.in[19]; const float* ffn2_wu = args.in[20]; const float* ffn2_wd = args.in[21]; const float* final_norm = args.in[22];
    float* out = args.out;
    float* ssq0 = (float*)(ws + WS_SSQ0); float* ssq1 = (float*)(ws + WS_SSQ1); float* ssq2 = (float*)(ws + WS_SSQ2); float* ssq3 = (float*)(ws + WS_SSQ3);
    float* ltab = (float*)(ws + WS_LTAB);
    bf16_t* Win_t = (bf16_t*)(ws + WS_WIN); bf16_t* Wgate_t = (bf16_t*)(ws + WS_WGATE); bf16_t* Wpa_t = (bf16_t*)(ws + WS_WPA); bf16_t* Wpb_t = (bf16_t*)(ws + WS_WPB); bf16_t* Wout_t = (bf16_t*)(ws + WS_WOUT);
    bf16_t* W1gu_t = (bf16_t*)(ws + WS_W1GU); bf16_t* W1d_t = (bf16_t*)(ws + WS_W1D); bf16_t* W2gu_t = (bf16_t*)(ws + WS_W2GU); bf16_t* W2d_t = (bf16_t*)(ws + WS_W2D);
    bf16_t* HB = (bf16_t*)(ws + WS_HB); bf16_t* ACT = (bf16_t*)(ws + WS_ACT); bf16_t* QKV = (bf16_t*)(ws + WS_QKV); bf16_t* Y = (bf16_t*)(ws + WS_Y);
    bf16_t* PA = (bf16_t*)(ws + WS_PA); bf16_t* PB = (bf16_t*)(ws + WS_PB); bf16_t* MB = (bf16_t*)(ws + WS_M);

    for (int u = tid; u < (LDS_BYTES - LDSCTL_OFF) / 4; u += NWAVES * 64) ((LAS unsigned*)(lds + LDSCTL_OFF))[u] = 0u;
    __syncthreads();
#if MK_ONE_LAUNCH
    XcdBarrier bar = xcd_barrier_post((unsigned*)(ctl + CW_BAR), MISC + 8);
#if PROBE_ON
    unsigned pr_bar = 0;
#define GRID_BAR() do { const unsigned _t0 = (unsigned)__builtin_amdgcn_s_memrealtime(); xcd_barrier(bar); pr_bar += (unsigned)__builtin_amdgcn_s_memrealtime() - _t0; if (bx == 0 && tid == 0) __hip_atomic_store(ctl + 32 + 30, pr_bar, RLX_AGENT); } while (0)
#else
#define GRID_BAR() xcd_barrier(bar)
#endif
#else
#define GRID_BAR() do { } while (0)
#endif
    const int lo = args.ph_lo, hi = args.ph_hi;
#define IN(k) (lo <= (k) && (k) < hi)
#define BOTH(k) (IN(k) && IN((k) + 1))
#if PROBE_ON
#define STAMP(k) do { if (bx == 0 && tid == 0) __hip_atomic_store(ctl + 16 + (k), (unsigned)__builtin_amdgcn_s_memrealtime(), RLX_AGENT); } while (0)
#else
#define STAMP(k) do { } while (0)
#endif
    const int gw = vcu * NWAVES + wave, NGW = G * NWAVES;

    if (IN(0)) {
        STAMP(0);
        LAS float* scr = (LAS float*)(lds + wave * 16384);
        constexpr int I_GU = (DM / 64) * (DFF / 32), I_D = (DFF / 64) * (DM / 32), I_IN = (DM / 64) * (NQKV / 32), I_GT = (DM / 64) * (2 * DM / 32), I_PA = (256 / 64) * (DM / 32), I_PB = (512 / 64) * (DM / 32), I_O = (DM / 64) * (DM / 32);
        constexpr int NITEMS = 4 * I_GU + 2 * I_D + I_IN + I_GT + I_PA + I_PB + I_O;
        for (int it = gw; it < NITEMS; it += NGW) {
            int r = it;
            if (r < I_GU) { transpose_item<1, true>(ffn1_wg, DM, DFF, W1gu_t, ffn1_norm, scr, r, lane); continue; } r -= I_GU;
            if (r < I_GU) { transpose_item<2, true>(ffn1_wu, DM, DFF, W1gu_t, ffn1_norm, scr, r, lane); continue; } r -= I_GU;
            if (r < I_D)  { transpose_item<3, false>(ffn1_wd, DFF, DM, W1d_t, nullptr, scr, r, lane); continue; } r -= I_D;
            if (r < I_IN) { transpose_item<3, true>(w_in, DM, NQKV, Win_t, mix_norm, scr, r, lane); continue; } r -= I_IN;
            if (r < I_GT) {
                if ((r % (2 * DM / 32)) < DM / 32) transpose_item<1, true>(w_gate, DM, 2 * DM, Wgate_t, mix_norm, scr, r, lane);
                else transpose_item<2, true>(w_gate, DM, 2 * DM, Wgate_t, mix_norm, scr, r, lane, DM);
                continue; } r -= I_GT;
            if (r < I_PA) { transpose_item<4, false>(w_proj_a, 256, DM, Wpa_t, nullptr, scr, r, lane); continue; } r -= I_PA;
            if (r < I_PB) { transpose_item<4, false>(w_proj_b, 512, DM, Wpb_t, nullptr, scr, r, lane); continue; } r -= I_PB;
            if (r < I_O)  { transpose_item<3, false>(w_out, DM, DM, Wout_t, nullptr, scr, r, lane); continue; } r -= I_O;
            if (r < I_GU) { transpose_item<1, true>(ffn2_wg, DM, DFF, W2gu_t, ffn2_norm, scr, r, lane); continue; } r -= I_GU;
            if (r < I_GU) { transpose_item<2, true>(ffn2_wu, DM, DFF, W2gu_t, ffn2_norm, scr, r, lane); continue; } r -= I_GU;
            transpose_item<3, false>(ffn2_wd, DFF, DM, W2d_t, nullptr, scr, r, lane);
        }
        for (int m0 = gw * 4; m0 < NTOK; m0 += NGW * 4) {
            const float* xrow = (m0 < NTOK_PROMPT) ? x_prompt + (size_t)m0 * DM : x_sample + (size_t)(m0 - NTOK_PROMPT) * DM;
            f32x4 v[4][4]; float sq[4];
#pragma unroll
            for (int q = 0; q < 4; ++q)
#pragma unroll
                for (int j = 0; j < 4; ++j) v[q][j] = ((const f32x4*)(xrow + (size_t)q * DM))[lane + 64 * j];
#pragma unroll
            for (int q = 0; q < 4; ++q) { float t = 0.f;
#pragma unroll
                for (int j = 0; j < 4; ++j) t += (v[q][j][0] * v[q][j][0] + v[q][j][1] * v[q][j][1]) + (v[q][j][2] * v[q][j][2] + v[q][j][3] * v[q][j][3]);
                sq[q] = t; }
#pragma unroll
            for (int o = 1; o < 64; o <<= 1) {
#pragma unroll
                for (int q = 0; q < 4; ++q) sq[q] += __shfl_xor(sq[q], o); }
#pragma unroll
            for (int q = 0; q < 4; ++q) { u32x2* o8 = (u32x2*)(HB + (size_t)(m0 + q) * DM) + lane;
#pragma unroll
                for (int j = 0; j < 4; ++j) { u32x2 w; w.x = cvtpk(v[q][j][0], v[q][j][1]); w.y = cvtpk(v[q][j][2], v[q][j][3]); o8[64 * j] = w; } }
            { const int q = lane >> 4, i = lane & 15; const float sv = (q == 0) ? sq[0] : (q == 1) ? sq[1] : (q == 2) ? sq[2] : sq[3]; ssq0[(size_t)(m0 + q) * 16 + i] = (i == 0) ? sv : 0.f; }
        }
        if (BOTH(0)) GRID_BAR();
    }
    if (IN(1)) {
        STAMP(1);
        pg8::Gemm g{HB, W1gu_t, NTOK, 2 * DFF, DM, DM}; pg8::StaticOrder S; S.init(NTOK, 2 * DFF, G, bx);
        pg8::EpiSwiGLU E{ACT, ssq0, {-1, 0.f, 0.f}, 0};
        pg8::gemm_phase(lds, g, S, E, (unsigned*)(ctl + 32 + 2 * 1));
        if (BOTH(1)) GRID_BAR();
    }
    if (IN(2)) {
        STAMP(2);
        pg8::Gemm g{ACT, W1d_t, NTOK, DM, DFF, DFF}; pg8::StaticOrder S; S.init(NTOK, DM, G, bx);
        pg8::EpiRes<false> E{HB, nullptr, ssq1, 0.5f};
        pg8::gemm_phase(lds, g, S, E, (unsigned*)(ctl + 32 + 2 * 2));
        if (BOTH(2)) GRID_BAR();
    }
    if (IN(3)) {
        STAMP(3);
        pg8::Gemm g{HB, Win_t, NTOK, NQKV, DM, DM}; pg8::StaticOrder S; S.init(NTOK, NQKV, G, bx);
        pg8::EpiQKV E{QKV, ssq1, a_q_norm, a_k_norm, b_q_norm, b_k_norm, {-1, 0.f, 0.f}};
        pg8::gemm_phase(lds, g, S, E, (unsigned*)(ctl + 32 + 2 * 3));
        if (BOTH(3)) GRID_BAR();
    }
    if (IN(4)) {
        STAMP(4);
        struct AUnit { att::KVSrc src; bf16_t* Qg; long rstride; float nslope2; int jlo_u, jhi_u, head; long tok0; int d; };
        auto decodeA = [&](int ua) -> AUnit {
            AUnit a; const int head = ua % 12, chunk = ua / 12, grp = head >> 2, dsh = 2 * grp, d = 1 << dsh;
            int sbase, T, c;
            if (chunk < 32) { sbase = 0; T = T_PROMPT; c = chunk; } else if (chunk < 64) { sbase = T_PROMPT; T = T_PROMPT; c = chunk - 32; }
            else if (chunk < 128) { sbase = 2 * T_PROMPT; T = T_SAMPLE; c = chunk - 64; } else { sbase = 2 * T_PROMPT + T_SAMPLE; T = T_SAMPLE; c = chunk - 128; }
            const int r = c & (d - 1), b = c >> dsh, nblk = (T >> dsh) / 256;
            a.jlo_u = (b == 0) ? 1 : 0; a.jhi_u = (b == nblk - 1) ? 4 : 5;
            a.rstride = (long)d * NQKV; a.head = head; a.d = d;
            bf16_t* base = QKV + (long)(sbase + r) * NQKV + head * 64;
            a.src.Kg = base + 768 + (long)(256 * b - 64) * a.rstride; a.src.Vg = base + 1536 + (long)(256 * b - 64) * a.rstride; a.src.rstride = a.rstride;
            a.src.row_lo = 64 * a.jlo_u; a.src.row_hi = 64 * a.jhi_u + 64;
            a.Qg = base + (long)(256 * b) * a.rstride; a.tok0 = (long)(sbase + r) + (long)(256 * b) * d;
            a.nslope2 = -fast_exp2(-8.0f * (float)(head + 1) / 12.0f) * LOG2E * (float)d;
            return a; };
        {
            constexpr int NA = (NTOK / 256) * 12;
            u32x4 kv[6], vv[6];
            bf16x8 qn[4];
            if (bx < NA) { const AUnit f = decodeA(bx); att::load_kv<6>(f.src, kv, vv, tid); att::load_q(f.Qg + (long)(32 * wave) * f.rstride, f.rstride, qn); }
            for (int ua = bx; ua < NA; ua += G) {
                const AUnit cur = decodeA(ua);
                att::write_kv<6>(lds, cur.src, kv, vv, tid);
                __syncthreads();
                const int w = wave;
                bf16_t* Qg = cur.Qg + (long)(32 * w) * cur.rstride;
                bf16x8 qr[4];
#pragma unroll
                for (int i = 0; i < 4; ++i) qr[i] = qn[i];
                if (ua + G < NA) { const AUnit nxt = decodeA(ua + G); att::load_kv<6>(nxt.src, kv, vv, tid); att::load_q(nxt.Qg + (long)(32 * w) * nxt.rstride, nxt.rstride, qn); }
                {
                    const int hlo = w > 2 * cur.jlo_u ? w : 2 * cur.jlo_u; const int hhi = (w + 4) < (2 * cur.jhi_u + 1) ? (w + 4) : (2 * cur.jhi_u + 1);
                    f32x16 o0, o1; float l;
                    att::attn_task<64>(lds, qr, hlo, hhi, 64 + 32 * w, cur.nslope2, o0, o1, l);
                    if (lane < 32) ltab[(size_t)(cur.tok0 + (long)(32 * w + lane) * cur.d) * 12 + cur.head] = l;
                    att::attn_store(lds, o0, o1, l, 0.f, Qg, cur.rstride, w);
                }
                __syncthreads();
            }
        }
        struct BUnit { att::KVSrc src; const bf16_t* Qg; bf16_t* Og; int jlo_u, jhi_u, kvh; };
        auto decodeB = [&](int ub) -> BUnit {
            BUnit u; const int kvh = ub & 1, t0 = (ub >> 1) * 64;
            int sbase, T;
            if (t0 < T_PROMPT) { sbase = 0; T = T_PROMPT; } else if (t0 < 2 * T_PROMPT) { sbase = T_PROMPT; T = T_PROMPT; }
            else if (t0 < 2 * T_PROMPT + T_SAMPLE) { sbase = 2 * T_PROMPT; T = T_SAMPLE; } else { sbase = 2 * T_PROMPT + T_SAMPLE; T = T_SAMPLE; }
            const int b = (t0 - sbase) / 64, nb = T / 64;
            u.jlo_u = (2 - b) > 0 ? (2 - b) : 0; u.jhi_u = (nb + 1 - b) < 4 ? (nb + 1 - b) : 4; u.kvh = kvh;
            u.src.Kg = QKV + (long)(sbase + 64 * (b - 2)) * NQKV + 2816 + kvh * 64; u.src.Vg = u.src.Kg + 128; u.src.rstride = (long)NQKV;
            u.src.row_lo = 64 * u.jlo_u; u.src.row_hi = 64 * u.jhi_u + 64;
            u.Qg = QKV + (long)(sbase + 64 * b) * NQKV + 2304 + kvh * 256; u.Og = Y + (long)(sbase + 64 * b) * NY + 256 + kvh * 256;
            return u; };
        {
            constexpr int NB = (NTOK / 64) * 2;
            u32x4 kv[5], vv[5];
            bf16x8 qn[4];
            if (bx < NB) { const BUnit f = decodeB(bx); att::load_kv<5>(f.src, kv, vv, tid); att::load_q(f.Qg + (long)(32 * (wave & 1)) * NQKV + (wave >> 1) * 64, (long)NQKV, qn); }
            for (int ub = bx; ub < NB; ub += G) {
                const BUnit cur = decodeB(ub);
                att::write_kv<5>(lds, cur.src, kv, vv, tid);
                __syncthreads();
                const int w = wave, hq = w >> 1, half = w & 1, h = cur.kvh * 4 + hq;
                bf16x8 qr[4];
#pragma unroll
                for (int i = 0; i < 4; ++i) qr[i] = qn[i];
                if (ub + G < NB) { const BUnit nxt = decodeB(ub + G); att::load_kv<5>(nxt.src, kv, vv, tid); att::load_q(nxt.Qg + (long)(32 * half) * NQKV + hq * 64, (long)NQKV, qn); }
                {
                    const float slope = fast_exp2(-(float)(h + 1));
                    f32x16 o0, o1; float l;
                    const int hlo = half > 2 * cur.jlo_u ? half : 2 * cur.jlo_u; const int hhi = (half + 8) < (2 * cur.jhi_u + 1) ? (half + 8) : (2 * cur.jhi_u + 1);
                    att::attn_task<128>(lds, qr, hlo, hhi, 128 + 32 * half, -slope * LOG2E, o0, o1, l);
                    const float extra = fast_exp2(b_sink[h] * LOG2E);
                    att::attn_store(lds, o0, o1, l, extra, cur.Og + (long)(32 * half) * NY + hq * 64, (long)NY, w);
                }
                __syncthreads();
            }
        }
        if (BOTH(4)) GRID_BAR();
    }
    if (IN(5)) {
        STAMP(5);
        const int gt = vcu * (NWAVES * 64) + tid, NT = G * NWAVES * 64;
        for (int idx = gt; idx < NTOK * 32; idx += NT) {
            const int tok = idx >> 5, part = idx & 31, sl = part >> 3, dch = part & 7;
            const float l0 = ltab[(size_t)tok * 12 + sl], l1 = ltab[(size_t)tok * 12 + 4 + sl], l2 = ltab[(size_t)tok * 12 + 8 + sl];
            const float inv = fast_rcp(l0 + l1 + l2); const float a0 = l0 * inv, a1 = l1 * inv, a2 = l2 * inv;
            const bf16_t* p = QKV + (size_t)tok * NQKV + sl * 64 + dch * 8;
            const u32x4 x0 = *(const u32x4*)p, x1 = *(const u32x4*)(p + 256), x2 = *(const u32x4*)(p + 512);
            u32x4 o;
#pragma unroll
            for (int i = 0; i < 4; ++i) o[i] = cvtpk(a0 * bf_lo(x0[i]) + a1 * bf_lo(x1[i]) + a2 * bf_lo(x2[i]), a0 * bf_hi(x0[i]) + a1 * bf_hi(x1[i]) + a2 * bf_hi(x2[i]));
            *(u32x4*)(Y + (size_t)tok * NY + sl * 64 + dch * 8) = o;
        }
        if (BOTH(5)) GRID_BAR();
    }
    if (IN(6)) {
        STAMP(6);
        { pg8::Gemm g{Y, Wpa_t, NTOK, DM, 256, NY}; pg8::StaticOrder S; S.init(NTOK, DM, G, bx); pg8::EpiPlain E{PA, DM}; pg8::gemm_phase(lds, g, S, E); }
        { pg8::Gemm g{Y + 256, Wpb_t, NTOK, DM, 512, NY}; pg8::StaticOrder S; S.init(NTOK, DM, G, bx); pg8::EpiPlain E{PB, DM}; pg8::gemm_phase(lds, g, S, E); }
        if (BOTH(6)) GRID_BAR();
    }
    if (IN(7)) {
        STAMP(7);
        pg8::Gemm g{HB, Wgate_t, NTOK, 2 * DM, DM, DM}; pg8::StaticOrder S; S.init(NTOK, 2 * DM, G, bx);
        pg8::EpiGate E{MB, ssq1, b_gate, PA, PB, {-1, 0.f, 0.f}};
        pg8::gemm_phase(lds, g, S, E, (unsigned*)(ctl + 32 + 2 * 7));
        if (BOTH(7)) GRID_BAR();
    }
    if (IN(8)) {
        STAMP(8);
        pg8::Gemm g{MB, Wout_t, NTOK, DM, DM, DM}; pg8::StaticOrder S; S.init(NTOK, DM, G, bx);
        pg8::EpiRes<false> E{HB, nullptr, ssq2, 1.0f};
        pg8::gemm_phase(lds, g, S, E, (unsigned*)(ctl + 32 + 2 * 8));
        if (BOTH(8)) GRID_BAR();
    }
    if (IN(9)) {
        STAMP(9);
        pg8::Gemm g{HB, W2gu_t, NTOK, 2 * DFF, DM, DM}; pg8::StaticOrder S; S.init(NTOK, 2 * DFF, G, bx);
        pg8::EpiSwiGLU E{ACT, ssq2, {-1, 0.f, 0.f}, 0};
        pg8::gemm_phase(lds, g, S, E, (unsigned*)(ctl + 32 + 2 * 9));
        if (BOTH(9)) GRID_BAR();
    }
    if (IN(10)) {
        STAMP(10);
        pg8::Gemm g{ACT, W2d_t, NTOK, DM, DFF, DFF}; pg8::StaticOrder S; S.init(NTOK, DM, G, bx);
        pg8::EpiRes<false> E{HB, nullptr, ssq3, 0.5f};
        pg8::gemm_phase(lds, g, S, E, (unsigned*)(ctl + 32 + 2 * 10));
        if (BOTH(10)) GRID_BAR();
    }
    if (IN(11)) {
        STAMP(11);
        f32x4 gfin[4];
#pragma unroll
        for (int j = 0; j < 4; ++j) gfin[j] = ((const f32x4*)final_norm)[lane + 64 * j];
        for (int m0 = gw * 4; m0 < NTOK; m0 += NGW * 4) {
            u32x2 v[4][4]; float sq[4];
            { const f32x4 t = ((const f32x4*)(ssq3 + (size_t)m0 * 16))[lane & 15];
              float a = (t[0] + t[1]) + (t[2] + t[3]); a += __shfl_xor(a, 1); a += __shfl_xor(a, 2);
#pragma unroll
              for (int q = 0; q < 4; ++q) sq[q] = __shfl(a, 4 * q); }
#pragma unroll
            for (int q = 0; q < 4; ++q)
#pragma unroll
                for (int j = 0; j < 4; ++j) v[q][j] = ((const u32x2*)(HB + (size_t)(m0 + q) * DM))[lane + 64 * j];
#pragma unroll
            for (int q = 0; q < 4; ++q) { const float rr = fast_rsq(sq[q] * (1.0f / DM) + NORM_EPS);
#pragma unroll
                for (int j = 0; j < 4; ++j) { f32x4 h; h[0] = bf_lo(v[q][j].x); h[1] = bf_hi(v[q][j].x); h[2] = bf_lo(v[q][j].y); h[3] = bf_hi(v[q][j].y);
                    ((f32x4*)(out + (size_t)(m0 + q) * DM))[lane + 64 * j] = h * rr * gfin[j]; } }
        }
#if PROBE_ON
        GRID_BAR();
        STAMP(12);
        GRID_BAR();
        float probe_scale = 1.0f, probe_x = 0.f;
        if (PROBE_A >= 100) { probe_scale = 1.025f + (float)__hip_atomic_load(ctl + 32 + (PROBE_A >= 100 ? PROBE_A - 100 : 0), RLX_AGENT) * 0.01f * (1.0f / 20000.0f); }
        else if (PROBE_A >= 0) { const unsigned t0 = __hip_atomic_load(ctl + 16 + (PROBE_A >= 0 ? PROBE_A : 0), RLX_AGENT), t1 = __hip_atomic_load(ctl + 17 + (PROBE_A >= 0 ? PROBE_A : 0), RLX_AGENT); probe_scale = 1.025f + (float)(t1 - t0) * 0.01f * (1.0f / 20000.0f); }
        if (PROBE_B >= 100) { probe_x = 20.0f + (float)__hip_atomic_load(ctl + 32 + (PROBE_B >= 100 ? PROBE_B - 100 : 0), RLX_AGENT) * 0.01f * 0.05f; }
        else if (PROBE_B >= 0) { const unsigned t0 = __hip_atomic_load(ctl + 16 + (PROBE_B >= 0 ? PROBE_B : 0), RLX_AGENT), t1 = __hip_atomic_load(ctl + 17 + (PROBE_B >= 0 ? PROBE_B : 0), RLX_AGENT); probe_x = 20.0f + (float)(t1 - t0) * 0.01f * 0.05f; }
        for (int m = NTOK_PROMPT + gw; m < NTOK; m += NGW) { f32x4* xr = (f32x4*)(out + (size_t)m * DM) + lane;
#pragma unroll
            for (int j = 0; j < 4; ++j) xr[64 * j] = xr[64 * j] * probe_scale; }
        if (PROBE_B >= 0 && bx == 0 && tid == 0) out[0] = probe_x;
#endif
    }
#undef IN
#undef BOTH
}

extern "C" void kernel_launch(void* const* d_in, const int* in_sizes, int n_in, void* d_out, int out_size, void* d_ws, size_t ws_size, hipStream_t stream) {
    static int grid = 0;
    if (grid == 0) {
        if (n_in != 23 || out_size != NTOK * DM || ws_size < WS_END) { fprintf(stderr, "kernel_launch: unexpected problem (n_in %d, out %d, ws %zu); nothing launched\n", n_in, out_size, ws_size); grid = -1; return; }
        int dev = 0, cus = 0, per_cu = 0;
        if (hipGetDevice(&dev) != hipSuccess || hipDeviceGetAttribute(&cus, hipDeviceAttributeMultiprocessorCount, dev) != hipSuccess) { fprintf(stderr, "kernel_launch: device query failed\n"); grid = -1; return; }
        if (hipFuncSetAttribute((const void*)enc_fwd, hipFuncAttributeMaxDynamicSharedMemorySize, LDS_BYTES) != hipSuccess) { fprintf(stderr, "kernel_launch: hipFuncSetAttribute failed\n"); grid = -1; return; }
        if (hipOccupancyMaxActiveBlocksPerMultiprocessor(&per_cu, (const void*)enc_fwd, NWAVES * 64, LDS_BYTES) != hipSuccess || per_cu < 1)
            fprintf(stderr, "kernel_launch: note: occupancy query reports %d workgroups per CU\n", per_cu);
        (void)hipGetLastError();
        grid = cus;
    }
    if (grid < 0) return;
    if (hipMemsetAsync((char*)d_ws + WS_CTL, 0, CTL_ZERO_BYTES, stream) != hipSuccess) { fprintf(stderr, "kernel_launch: memset failed\n"); return; }
    Args a{};
    for (int i = 0; i < 23; ++i) a.in[i] = (const float*)d_in[i];
    a.out = (float*)d_out; a.ws = (unsigned char*)d_ws;
#if MK_ONE_LAUNCH
    a.ph_lo = 0; a.ph_hi = NPHASE;
    hipLaunchKernelGGL(enc_fwd, dim3(grid), dim3(NWAVES * 64), LDS_BYTES, stream, a);
#else
    for (int p = 0; p < NPHASE; ++p) { a.ph_lo = p; a.ph_hi = p + 1; hipLaunchKernelGGL(enc_fwd, dim3(grid), dim3(NWAVES * 64), LDS_BYTES, stream, a); }
#endif
    const hipError_t le = hipPeekAtLastError();
    if (le != hipSuccess) fprintf(stderr, "kernel_launch: launch failed: %s\n", hipGetErrorName(le));
}
```
